# Optimizing an MI355X kernel written in HIP

```python
import math
import jax, jax.numpy as jnp
from jax import lax
import numpy as np

D_MODEL = 1024
BATCH = 8
SEQ = 4096
DEPTH = 2

N_A_LAYERS = DEPTH // 2
N_B_LAYERS = DEPTH - N_A_LAYERS
S5_GROUP = 16
S5_GROUPS = D_MODEL // S5_GROUP
S5_STATE = 64
DT_MIN = 1e-3
DT_MAX = 1e-1
N_HEADS = 16
HEAD_DIM = D_MODEL // N_HEADS
Q_BLOCK = 128
N_EXPERT_GROUPS = 4
EXPERTS_PER_GROUP = 8
N_EXPERTS = N_EXPERT_GROUPS * EXPERTS_PER_GROUP
TOP_K = 2
D_EXPERT = D_MODEL // 4
EPS = 1e-6
NEG = -1e30

kernel_name = "yoco_s5_fox_hier_moe_adaln"


def rmsnorm(x, g):
    x32 = x.astype(jnp.float32)
    y = x32 * lax.rsqrt(jnp.mean(x32 * x32, axis=-1, keepdims=True) + EPS)
    return (y * g.astype(jnp.float32)).astype(x.dtype)


def adaln(c, w, b, n):
    mod = jax.nn.silu(c) @ w + b
    return jnp.split(mod, n, axis=-1)


def modulate(h, shift, scale):
    return h * (1.0 + scale[:, None, :]) + shift[:, None, :]


def _complex_combine(e1, e2):
    ar1, ai1, br1, bi1 = e1
    ar2, ai2, br2, bi2 = e2
    ar = ar2 * ar1 - ai2 * ai1
    ai = ar2 * ai1 + ai2 * ar1
    br = ar2 * br1 - ai2 * bi1 + br2
    bi = ar2 * bi1 + ai2 * br1 + bi2
    return (ar, ai, br, bi)


def s5_mixer(h, w_in, lam_re, lam_im, log_dt, b_re, b_im, c_re, c_im, d_skip, w_out):
    bsz, seq, _ = h.shape
    u = (h @ w_in).astype(jnp.float32)
    ug = u.reshape(bsz, seq, S5_GROUPS, S5_GROUP)
    dt = jnp.exp(log_dt.astype(jnp.float32))[:, None]
    lr = lam_re.astype(jnp.float32)
    li = lam_im.astype(jnp.float32)
    mag = jnp.exp(lr * dt)
    a_re = mag * jnp.cos(li * dt)
    a_im = mag * jnp.sin(li * dt)
    den = lr * lr + li * li
    coef_re = ((a_re - 1.0) * lr + a_im * li) / den
    coef_im = (a_im * lr - (a_re - 1.0) * li) / den
    br_, bi_ = b_re.astype(jnp.float32), b_im.astype(jnp.float32)
    bbar_re = coef_re[..., None] * br_ - coef_im[..., None] * bi_
    bbar_im = coef_re[..., None] * bi_ + coef_im[..., None] * br_
    bu_re = jnp.einsum('blgc,gpc->blgp', ug, bbar_re)
    bu_im = jnp.einsum('blgc,gpc->blgp', ug, bbar_im)
    shape_a = (1, seq, S5_GROUPS, S5_STATE)
    a_re_l = jnp.broadcast_to(a_re[None, None], shape_a)
    a_im_l = jnp.broadcast_to(a_im[None, None], shape_a)
    _, _, s_re, s_im = lax.associative_scan(_complex_combine, (a_re_l, a_im_l, bu_re, bu_im), axis=1)
    y = (jnp.einsum('blgp,gcp->blgc', s_re, c_re.astype(jnp.float32))
         - jnp.einsum('blgp,gcp->blgc', s_im, c_im.astype(jnp.float32)))
    y = y.reshape(bsz, seq, D_MODEL) + d_skip.astype(jnp.float32) * u
    y = jax.nn.gelu(y).astype(h.dtype)
    val, gate = jnp.split(y @ w_out, 2, axis=-1)
    return val * jax.nn.sigmoid(gate)


def shared_kv(x, c, kv_g, kv_ada_w, kv_ada_b, kv_w, kv_fb, k_norm_g):
    bsz, seq, _ = x.shape
    shift, scale = adaln(c, kv_ada_w, kv_ada_b, 2)
    h = modulate(rmsnorm(x, kv_g), shift, scale)
    k, v, fz = jnp.split(h @ kv_w, [D_MODEL, 2 * D_MODEL], axis=-1)
    k = rmsnorm(k.reshape(bsz, seq, N_HEADS, HEAD_DIM), k_norm_g).transpose(0, 2, 1, 3)
    v = v.reshape(bsz, seq, N_HEADS, HEAD_DIM).transpose(0, 2, 1, 3)
    logf = jax.nn.log_sigmoid(fz.astype(jnp.float32) + kv_fb.astype(jnp.float32))
    fcum = jnp.cumsum(logf, axis=1).transpose(0, 2, 1)
    return k, v, fcum


def fox_mixer(h, w_qg, q_norm_g, w_o, k, v, fcum):
    bsz, seq, _ = h.shape
    q, og = jnp.split(h @ w_qg, 2, axis=-1)
    q = rmsnorm(q.reshape(bsz, seq, N_HEADS, HEAD_DIM), q_norm_g).transpose(0, 2, 1, 3)
    scale = HEAD_DIM ** -0.5
    outs = []
    for i in range(seq // Q_BLOCK):
        s0 = i * Q_BLOCK
        s1 = s0 + Q_BLOCK
        qb = q[:, :, s0:s1]
        kb = k[:, :, :s1]
        vb = v[:, :, :s1]
        logits = (jnp.einsum('bhqd,bhkd->bhqk', qb, kb).astype(jnp.float32) * scale
                  + fcum[:, :, s0:s1, None] - fcum[:, :, None, :s1])
        mask = (s0 + jnp.arange(Q_BLOCK))[:, None] >= jnp.arange(s1)[None, :]
        p = jax.nn.softmax(jnp.where(mask, logits, NEG), axis=-1)
        outs.append(jnp.einsum('bhqk,bhkd->bhqd', p.astype(vb.dtype), vb))
    o = jnp.concatenate(outs, axis=2).transpose(0, 2, 1, 3).reshape(bsz, seq, D_MODEL)
    return (o * jax.nn.sigmoid(og)) @ w_o


def hier_moe(h, wg, bg, we, be, w1, w3, w2):
    bsz, seq, d = h.shape
    t = h.reshape(-1, d)
    g_logits = (t @ wg + bg).astype(jnp.float32)
    g_prob = jax.nn.softmax(g_logits, axis=-1)
    g_top_v, g_idx = lax.top_k(g_logits, 1)
    p_g = jnp.take_along_axis(g_prob, g_idx, axis=1)
    e_logits = (t @ we + be).astype(jnp.float32).reshape(-1, N_EXPERT_GROUPS, EXPERTS_PER_GROUP)
    e_sel = jnp.take_along_axis(e_logits, g_idx[:, :, None], axis=1)[:, 0]
    top_v, top_i = lax.top_k(e_sel, TOP_K)
    w = jax.nn.softmax(top_v, axis=-1) * p_g
    eid = g_idx * EXPERTS_PER_GROUP + top_i
    gates = jnp.sum(jax.nn.one_hot(eid, N_EXPERTS, dtype=jnp.float32) * w[..., None], axis=1)
    out = jnp.zeros(t.shape, jnp.float32)
    for e in range(N_EXPERTS):
        y = (jax.nn.silu(t @ w1[e]) * (t @ w3[e])) @ w2[e]
        out = out + gates[:, e:e + 1] * y.astype(jnp.float32)
    return out.astype(h.dtype).reshape(bsz, seq, d)


def setup_inputs(seed: int = 0) -> dict:
    key = jax.random.key(seed)
    ks = iter(jax.random.split(key, 40))
    f32 = jnp.float32

    def nrm(shape, std):
        return std * jax.random.normal(next(ks), shape, f32)

    D, G, P, GC = D_MODEL, S5_GROUPS, S5_STATE, S5_GROUP
    H, HD, E, F, NG = N_HEADS, HEAD_DIM, N_EXPERTS, D_EXPERT, N_EXPERT_GROUPS
    NA, NB = N_A_LAYERS, N_B_LAYERS
    x = nrm((BATCH, SEQ, D), 1.0)
    c = nrm((BATCH, D), 1.0)
    ln_g = 1.0 + nrm((DEPTH, 2, D), 0.02)
    ada_w = nrm((DEPTH, 2, D, 3 * D), 0.5 * D ** -0.5)
    ada_b = nrm((DEPTH, 2, 3 * D), 0.02)
    s5_w_in = nrm((NA, D, D), D ** -0.5)
    n_idx = jnp.arange(P, dtype=f32)
    s5_lambda_re = -0.5 * jnp.exp(nrm((NA, G, P), 0.05))
    s5_lambda_im = math.pi * n_idx + nrm((NA, G, P), 0.01)
    s5_log_dt = jax.random.uniform(next(ks), (NA, G), f32, math.log(DT_MIN), math.log(DT_MAX))
    s5_b_re = nrm((NA, G, P, GC), (2 * GC) ** -0.5)
    s5_b_im = nrm((NA, G, P, GC), (2 * GC) ** -0.5)
    s5_c_re = nrm((NA, G, GC, P), P ** -0.5)
    s5_c_im = nrm((NA, G, GC, P), P ** -0.5)
    s5_d = nrm((NA, D), 0.5)
    s5_w_out = nrm((NA, D, 2 * D), D ** -0.5)
    kv_g = 1.0 + nrm((D,), 0.02)
    kv_ada_w = nrm((D, 2 * D), 0.5 * D ** -0.5)
    kv_ada_b = nrm((2 * D,), 0.02)
    kv_w = nrm((D, 2 * D + H), D ** -0.5)
    kv_fb = jax.random.uniform(next(ks), (H,), f32, 1.0, 6.0)
    k_norm_g = 1.0 + nrm((HD,), 0.02)
    fox_w_qg = nrm((NB, D, 2 * D), D ** -0.5)
    fox_q_norm_g = 1.0 + nrm((NB, HD), 0.02)
    fox_w_o = nrm((NB, D, D), D ** -0.5)
    moe_wg = nrm((DEPTH, D, NG), D ** -0.5)
    moe_bg = nrm((DEPTH, NG), 0.01)
    moe_we = nrm((DEPTH, D, E), D ** -0.5)
    moe_be = nrm((DEPTH, E), 0.01)
    moe_w1 = nrm((DEPTH, E, D, F), D ** -0.5)
    moe_w3 = nrm((DEPTH, E, D, F), D ** -0.5)
    moe_w2 = nrm((DEPTH, E, F, D), F ** -0.5)
    return {"x": x, "c": c, "ln_g": ln_g, "ada_w": ada_w, "ada_b": ada_b,
            "s5_w_in": s5_w_in, "s5_lambda_re": s5_lambda_re, "s5_lambda_im": s5_lambda_im,
            "s5_log_dt": s5_log_dt, "s5_b_re": s5_b_re, "s5_b_im": s5_b_im,
            "s5_c_re": s5_c_re, "s5_c_im": s5_c_im, "s5_d": s5_d, "s5_w_out": s5_w_out,
            "kv_g": kv_g, "kv_ada_w": kv_ada_w, "kv_ada_b": kv_ada_b, "kv_w": kv_w,
            "kv_fb": kv_fb, "k_norm_g": k_norm_g,
            "fox_w_qg": fox_w_qg, "fox_q_norm_g": fox_q_norm_g, "fox_w_o": fox_w_o,
            "moe_wg": moe_wg, "moe_bg": moe_bg, "moe_we": moe_we, "moe_be": moe_be,
            "moe_w1": moe_w1, "moe_w3": moe_w3, "moe_w2": moe_w2}


def reference(x, c, ln_g, ada_w, ada_b,
              s5_w_in, s5_lambda_re, s5_lambda_im, s5_log_dt, s5_b_re, s5_b_im,
              s5_c_re, s5_c_im, s5_d, s5_w_out,
              kv_g, kv_ada_w, kv_ada_b, kv_w, kv_fb, k_norm_g,
              fox_w_qg, fox_q_norm_g, fox_w_o,
              moe_wg, moe_bg, moe_we, moe_be, moe_w1, moe_w3, moe_w2):
    h = x
    k = v = fcum = None
    for l in range(DEPTH):
        shift, scale, gate = adaln(c, ada_w[l, 0], ada_b[l, 0], 3)
        hn = modulate(rmsnorm(h, ln_g[l, 0]), shift, scale)
        if l < N_A_LAYERS:
            mix = s5_mixer(hn, s5_w_in[l], s5_lambda_re[l], s5_lambda_im[l], s5_log_dt[l],
                           s5_b_re[l], s5_b_im[l], s5_c_re[l], s5_c_im[l], s5_d[l], s5_w_out[l])
        else:
            j = l - N_A_LAYERS
            mix = fox_mixer(hn, fox_w_qg[j], fox_q_norm_g[j], fox_w_o[j], k, v, fcum)
        h = h + gate[:, None, :] * mix
        shift, scale, gate = adaln(c, ada_w[l, 1], ada_b[l, 1], 3)
        hn = modulate(rmsnorm(h, ln_g[l, 1]), shift, scale)
        h = h + gate[:, None, :] * hier_moe(hn, moe_wg[l], moe_bg[l], moe_we[l], moe_be[l],
                                            moe_w1[l], moe_w3[l], moe_w2[l])
        if l == N_A_LAYERS - 1:
            k, v, fcum = shared_kv(h, c, kv_g, kv_ada_w, kv_ada_b, kv_w, kv_fb, k_norm_g)
    return h
```

```cpp
#include <hip/hip_runtime.h>
#include <cstdint>
#include <cstdio>

namespace ref {
constexpr int D = 1024, NB = 8, L = 4096, T = NB * L, G = 64, P = 64, GC = 16, H = 16, HD = 64, E = 32, F = 256;

__device__ __forceinline__ float siluf(float x) { return x / (1.0f + expf(-x)); }
__device__ __forceinline__ float sigmf(float x) { return 1.0f / (1.0f + expf(-x)); }
__device__ __forceinline__ float gelu_tanh(float x) { const float u = 0.7978845608028654f * (x + 0.044715f * x * x * x); return 0.5f * x * (1.0f + tanhf(u)); }
__device__ __forceinline__ unsigned short f2bf(float f) { unsigned u = __float_as_uint(f); u += 0x7FFFu + ((u >> 16) & 1u); return (unsigned short)(u >> 16); }
__device__ __forceinline__ float bf2f(unsigned short b) { return __uint_as_float(((unsigned)b) << 16); }

__global__ void k_mods(const float* __restrict__ c, const float* __restrict__ W, const float* __restrict__ bias, int N, float* __restrict__ out) {
    const int n = blockIdx.x * 256 + threadIdx.x, b = blockIdx.y;
    if (n >= N) return;
    float acc = 0.f;
    for (int d = 0; d < D; ++d) acc += siluf(c[b * D + d]) * W[(size_t)d * N + n];
    out[b * 3072 + n] = acc + bias[n];
}
__global__ void k_rmsmod(const float* __restrict__ h, const float* __restrict__ g, const float* __restrict__ mod  , float* __restrict__ out) {
    const int row = blockIdx.x, b = row / L, t = threadIdx.x;
    __shared__ float red[256];
    float v[4], s = 0.f;
    for (int i = 0; i < 4; ++i) { v[i] = h[(size_t)row * D + t + 256 * i]; s += v[i] * v[i]; }
    red[t] = s; __syncthreads();
    for (int o = 128; o > 0; o >>= 1) { if (t < o) red[t] += red[t + o]; __syncthreads(); }
    const float rstd = rsqrtf(red[0] / D + 1e-6f);
    for (int i = 0; i < 4; ++i) { const int d = t + 256 * i; out[(size_t)row * D + d] = v[i] * rstd * g[d] * (1.0f + mod[b * 3072 + 1024 + d]) + mod[b * 3072 + d]; }
}
__global__ void k_gemm(const float* __restrict__ A, int lda, const float* __restrict__ B, int ldb, float* __restrict__ C, int ldc, int M, int N, int K) {
    __shared__ float As[16][65], Bs[16][65];
    const int tx = threadIdx.x & 15, ty = threadIdx.x >> 4, m0 = blockIdx.y * 64, n0 = blockIdx.x * 64;
    float acc[4][4] = {};
    for (int k0 = 0; k0 < K; k0 += 16) {
        for (int i = threadIdx.x; i < 1024; i += 256) { const int r = i >> 4, kk = i & 15; As[kk][r] = A[(size_t)(m0 + r) * lda + k0 + kk]; }
        for (int i = threadIdx.x; i < 1024; i += 256) { const int kk = i >> 6, cidx = i & 63; Bs[kk][cidx] = (n0 + cidx < N) ? B[(size_t)(k0 + kk) * ldb + n0 + cidx] : 0.f; }
        __syncthreads();
#pragma unroll
        for (int kk = 0; kk < 16; ++kk) {
            float a[4], b[4];
#pragma unroll
            for (int i = 0; i < 4; ++i) { a[i] = As[kk][ty * 4 + i]; b[i] = Bs[kk][tx * 4 + i]; }
#pragma unroll
            for (int i = 0; i < 4; ++i)
#pragma unroll
                for (int j = 0; j < 4; ++j) acc[i][j] += a[i] * b[j];
        }
        __syncthreads();
    }
    for (int i = 0; i < 4; ++i) for (int j = 0; j < 4; ++j) { const int n = n0 + tx * 4 + j; if (n < N) C[(size_t)(m0 + ty * 4 + i) * ldc + n] = acc[i][j]; }
}
__global__ void k_s5_prep(const float* lre, const float* lim, const float* logdt, const float* bre, const float* bim, float* a_re, float* a_im, float* bb_re, float* bb_im) {
    const int g = blockIdx.x, p = threadIdx.x;
    const double dt = exp((double)logdt[g]), lr = lre[g * P + p], li = lim[g * P + p];
    const double mag = exp(lr * dt), ar = mag * cos(li * dt), ai = mag * sin(li * dt), den = lr * lr + li * li;
    const double cr = ((ar - 1.0) * lr + ai * li) / den, ci = (ai * lr - (ar - 1.0) * li) / den;
    a_re[g * P + p] = (float)ar; a_im[g * P + p] = (float)ai;
    for (int c = 0; c < GC; ++c) { const double br = bre[(g * P + p) * GC + c], bi = bim[(g * P + p) * GC + c];
        bb_re[(g * P + p) * GC + c] = (float)(cr * br - ci * bi); bb_im[(g * P + p) * GC + c] = (float)(cr * bi + ci * br); }
}
__global__ void __launch_bounds__(64) k_s5_scan(const float* __restrict__ u, const float* a_re, const float* a_im, const float* bb_re, const float* bb_im, const float* cre, const float* cim, const float* dskip, float* __restrict__ yg) {
    const int b = blockIdx.x / G, g = blockIdx.x % G, p = threadIdx.x;
    __shared__ float us[GC], sre[P], sim[P], crs[GC][P + 1], cis[GC][P + 1];
    float bbr[GC], bbi[GC];
#pragma unroll
    for (int c = 0; c < GC; ++c) { bbr[c] = bb_re[(g * P + p) * GC + c]; bbi[c] = bb_im[(g * P + p) * GC + c]; }
    for (int i = p; i < GC * P; i += 64) { crs[i / P][i % P] = cre[g * GC * P + i]; cis[i / P][i % P] = cim[g * GC * P + i]; }
    const float ar = a_re[g * P + p], ai = a_im[g * P + p], dsk = (p < GC) ? dskip[g * GC + p] : 0.f;
    float sr = 0.f, si = 0.f;
    __syncthreads();
    for (int t = 0; t < L; ++t) {
        const size_t base = ((size_t)(b * L + t)) * D + g * GC;
        if (p < GC) us[p] = u[base + p];
        __syncthreads();
        float br = 0.f, bi = 0.f;
#pragma unroll
        for (int c = 0; c < GC; ++c) { br += bbr[c] * us[c]; bi += bbi[c] * us[c]; }
        const float nr = ar * sr - ai * si + br, ni = ar * si + ai * sr + bi; sr = nr; si = ni;
        sre[p] = sr; sim[p] = si;
        __syncthreads();
        if (p < GC) { float y = 0.f;
            for (int q = 0; q < P; ++q) y += crs[p][q] * sre[q] - cis[p][q] * sim[q];
            y += dsk * us[p]; yg[base + p] = gelu_tanh(y); }
        __syncthreads();
    }
}
__global__ void k_glu_res(const float* __restrict__ hin, const float* __restrict__ proj, const float* __restrict__ mod, float* __restrict__ hout) {
    const size_t i = (size_t)blockIdx.x * 256 + threadIdx.x; const int row = (int)(i / D), d = (int)(i % D), b = row / L;
    const float val = proj[(size_t)row * 2048 + d], gt = proj[(size_t)row * 2048 + 1024 + d];
    hout[i] = hin[i] + mod[b * 3072 + 2048 + d] * val * sigmf(gt);
}
__global__ void k_res(const float* __restrict__ hin, const float* __restrict__ proj, const float* __restrict__ mod, float* __restrict__ hout) {
    const size_t i = (size_t)blockIdx.x * 256 + threadIdx.x; const int row = (int)(i / D), d = (int)(i % D), b = row / L;
    hout[i] = hin[i] + mod[b * 3072 + 2048 + d] * proj[i];
}
__global__ void k_route(const float* __restrict__ hn, const float* __restrict__ wg, const float* __restrict__ bg, const float* __restrict__ we, const float* __restrict__ be, int* __restrict__ eid, float* __restrict__ ew) {
    const int tok = blockIdx.x * 64 + threadIdx.x;
    float gl[4], el[32];
    for (int i = 0; i < 4; ++i) gl[i] = bg[i];
    for (int i = 0; i < 32; ++i) el[i] = be[i];
    for (int d = 0; d < D; ++d) { const float x = hn[(size_t)tok * D + d];
#pragma unroll
        for (int i = 0; i < 4; ++i) gl[i] += x * wg[d * 4 + i];
#pragma unroll
        for (int i = 0; i < 32; ++i) el[i] += x * we[d * 32 + i]; }
    int gi = 0; for (int i = 1; i < 4; ++i) if (gl[i] > gl[gi]) gi = i;
    float se = 0.f; for (int i = 0; i < 4; ++i) se += expf(gl[i] - gl[gi]);
    const float pg = 1.0f / se;
    float v1 = -3.0e38f, v2 = -3.0e38f; int i1 = 0, i2 = 0;
#pragma unroll
    for (int i = 0; i < 8; ++i) { float v = 0.f;
#pragma unroll
        for (int j = 0; j < 32; ++j) if (j == gi * 8 + i) v = el[j];
        if (v > v1) { v2 = v1; i2 = i1; v1 = v; i1 = i; } else if (v > v2) { v2 = v; i2 = i; } }
    const float e2 = expf(v2 - v1), w1 = 1.0f / (1.0f + e2), w2 = e2 / (1.0f + e2);
    eid[tok * 2] = gi * 8 + i1; eid[tok * 2 + 1] = gi * 8 + i2; ew[tok * 2] = w1 * pg; ew[tok * 2 + 1] = w2 * pg;
}
__global__ void k_moe_up(const float* __restrict__ hn, const int* __restrict__ eid, const float* __restrict__ w1, const float* __restrict__ w3, float* __restrict__ hmid) {
    const int tok = blockIdx.x, f = threadIdx.x;
    __shared__ float ts[D];
    for (int d = f; d < D; d += 256) ts[d] = hn[(size_t)tok * D + d];
    __syncthreads();
    for (int k = 0; k < 2; ++k) { const int e = eid[tok * 2 + k]; const float* p1 = w1 + (size_t)e * D * F + f; const float* p3 = w3 + (size_t)e * D * F + f;
        float a = 0.f, b = 0.f;
        for (int d = 0; d < D; ++d) { a += ts[d] * p1[(size_t)d * F]; b += ts[d] * p3[(size_t)d * F]; }
        hmid[((size_t)tok * 2 + k) * F + f] = siluf(a) * b; }
}
__global__ void k_moe_down(const float* __restrict__ hmid, const int* __restrict__ eid, const float* __restrict__ ew, const float* __restrict__ w2, const float* __restrict__ mod, const float* __restrict__ hin, float* __restrict__ hout) {
    const int tok = blockIdx.x, b = tok / L, t = threadIdx.x;
    __shared__ float hs[2 * F];
    for (int i = t; i < 2 * F; i += 256) hs[i] = hmid[(size_t)tok * 2 * F + i];
    __syncthreads();
    float acc[4] = {0.f, 0.f, 0.f, 0.f};
    for (int k = 0; k < 2; ++k) { const int e = eid[tok * 2 + k]; const float wk = ew[tok * 2 + k]; const float* pw = w2 + (size_t)e * F * D;
        float a[4] = {0.f, 0.f, 0.f, 0.f};
        for (int f = 0; f < F; ++f) { const float hv = hs[k * F + f];
#pragma unroll
            for (int i = 0; i < 4; ++i) a[i] += hv * pw[(size_t)f * D + t + 256 * i]; }
        for (int i = 0; i < 4; ++i) acc[i] += wk * a[i]; }
    for (int i = 0; i < 4; ++i) { const int d = t + 256 * i; hout[(size_t)tok * D + d] = hin[(size_t)tok * D + d] + mod[b * 3072 + 2048 + d] * acc[i]; }
}
__global__ void k_kvpost(const float* __restrict__ proj, const float* __restrict__ kg, const float* __restrict__ fb, unsigned short* __restrict__ Kb, unsigned short* __restrict__ Vb, float* __restrict__ logf) {
    const int tok = blockIdx.x, t = threadIdx.x  , b = tok / L, tt = tok % L;
    __shared__ float ss[16];
    const float* pr = proj + (size_t)tok * 2064;
    if (t < 16) { float s = 0.f; for (int d = 0; d < 64; ++d) { const float v = pr[t * 64 + d]; s += v * v; } ss[t] = rsqrtf(s / 64.0f + 1e-6f);
        const float z = pr[2048 + t] + fb[t]; logf[((size_t)b * H + t) * L + tt] = (z >= 0.f) ? -log1pf(expf(-z)) : (z - log1pf(expf(z))); }
    __syncthreads();
    for (int i = 0; i < 4; ++i) { const int d = t + 256 * i; Kb[(size_t)tok * D + d] = f2bf(pr[d] * ss[d >> 6] * kg[d & 63]); Vb[(size_t)tok * D + d] = f2bf(pr[1024 + d]); }
}
__global__ void k_cumsum(float* logf) { const int i = blockIdx.x * 64 + threadIdx.x; if (i >= NB * H) return; float* p = logf + (size_t)i * L; float s = 0.f; for (int t = 0; t < L; ++t) { s += p[t]; p[t] = s; } }
__global__ void k_qpost(float* __restrict__ q, const float* __restrict__ qg) {
    const int tok = blockIdx.x, t = threadIdx.x; __shared__ float ss[16];
    float* pr = q + (size_t)tok * D;
    if (t < 16) { float s = 0.f; for (int d = 0; d < 64; ++d) { const float v = pr[t * 64 + d]; s += v * v; } ss[t] = rsqrtf(s / 64.0f + 1e-6f); }
    __syncthreads();
    for (int i = 0; i < 4; ++i) { const int d = t + 256 * i; pr[d] = pr[d] * ss[d >> 6] * qg[d & 63]; }
}
__global__ void k_sig_bf(const float* __restrict__ x, unsigned short* __restrict__ o) { const size_t i = (size_t)blockIdx.x * 256 + threadIdx.x; o[i] = f2bf(sigmf(x[i])); }
__global__ void __launch_bounds__(64) k_attn(float* __restrict__ qo, const unsigned short* __restrict__ Kb, const unsigned short* __restrict__ Vb, const float* __restrict__ fcum, const unsigned short* __restrict__ gate) {
    const int qc = blockIdx.x % (L / 64), h = (blockIdx.x / (L / 64)) % H, b = blockIdx.x / (L / 64) / H;
    const int t = qc * 64 + threadIdx.x; const size_t row = (size_t)b * L + t;
    float q[64], o[64];
    for (int d = 0; d < 64; ++d) { q[d] = qo[row * D + h * 64 + d] * 0.125f; o[d] = 0.f; }
    const float* Fp = fcum + ((size_t)b * H + h) * L; const float ft = Fp[t];
    float m = -3.0e38f, l = 0.f;
    const int smax = qc * 64 + 63;
    for (int s = 0; s <= smax; ++s) {
        const unsigned short* kr = Kb + ((size_t)b * L + s) * D + h * 64; const unsigned short* vr = Vb + ((size_t)b * L + s) * D + h * 64;
        float dot = 0.f;
#pragma unroll
        for (int d = 0; d < 64; ++d) dot += q[d] * bf2f(kr[d]);
        const float x = dot + ft - Fp[s];
        if (s <= t) { const float mn = fmaxf(m, x), sc = expf(m - mn), pv = expf(x - mn); l = l * sc + pv;
#pragma unroll
            for (int d = 0; d < 64; ++d) o[d] = o[d] * sc + pv * bf2f(vr[d]);
            m = mn; }
    }
    const float il = 1.0f / l;
    for (int d = 0; d < 64; ++d) qo[row * D + h * 64 + d] = o[d] * il * bf2f(gate[row * D + h * 64 + d]);
}
}

extern "C" void kernel_launch(void* const* d_in, const int* in_sizes, int n_in, void* d_out, int out_size, void* d_ws, size_t ws_size, hipStream_t stream) {
    using namespace ref;
    const float* x = (const float*)d_in[0]; const float* c = (const float*)d_in[1]; const float* ln_g = (const float*)d_in[2]; const float* ada_w = (const float*)d_in[3]; const float* ada_b = (const float*)d_in[4];
    const float* s5_w_in = (const float*)d_in[5]; const float* s5_lre = (const float*)d_in[6]; const float* s5_lim = (const float*)d_in[7]; const float* s5_logdt = (const float*)d_in[8];
    const float* s5_bre = (const float*)d_in[9]; const float* s5_bim = (const float*)d_in[10]; const float* s5_cre = (const float*)d_in[11]; const float* s5_cim = (const float*)d_in[12];
    const float* s5_d = (const float*)d_in[13]; const float* s5_w_out = (const float*)d_in[14]; const float* kv_g = (const float*)d_in[15]; const float* kv_ada_w = (const float*)d_in[16];
    const float* kv_ada_b = (const float*)d_in[17]; const float* kv_w = (const float*)d_in[18]; const float* kv_fb = (const float*)d_in[19]; const float* k_norm_g = (const float*)d_in[20];
    const float* fox_w_qg = (const float*)d_in[21]; const float* fox_qng = (const float*)d_in[22]; const float* fox_w_o = (const float*)d_in[23];
    const float* moe_wg = (const float*)d_in[24]; const float* moe_bg = (const float*)d_in[25]; const float* moe_we = (const float*)d_in[26]; const float* moe_be = (const float*)d_in[27];
    const float* moe_w1 = (const float*)d_in[28]; const float* moe_w3 = (const float*)d_in[29]; const float* moe_w2 = (const float*)d_in[30];
    float* h = (float*)d_out;
    char* ws = (char*)d_ws; size_t off = 0;
    auto take = [&](size_t bytes) { void* p = ws + off; off += (bytes + 255) & ~(size_t)255; return p; };
    float* mods = (float*)take(5 * 8 * 3072 * 4);
    float* s5a_re = (float*)take(G * P * 4); float* s5a_im = (float*)take(G * P * 4); float* s5bb_re = (float*)take(G * P * GC * 4); float* s5bb_im = (float*)take(G * P * GC * 4);
    int* eid = (int*)take((size_t)T * 2 * 4); float* ew = (float*)take((size_t)T * 2 * 4); float* logf = (float*)take((size_t)NB * H * L * 4);
    float* hn = (float*)take((size_t)T * D * 4);
    char* big = (char*)take((size_t)T * 2064 * 4);
    float* proj = (float*)big;
    unsigned short* Gb = (unsigned short*)take((size_t)T * D * 2);
    if (off > ws_size) { fprintf(stderr, "ws too small\n"); return; }
    for (int s = 0; s < 4; ++s) hipLaunchKernelGGL(k_mods, dim3(12, 8), dim3(256), 0, stream, c, ada_w + (size_t)s * D * 3072, ada_b + s * 3072, 3072, mods + s * 8 * 3072);
    hipLaunchKernelGGL(k_mods, dim3(8, 8), dim3(256), 0, stream, c, kv_ada_w, kv_ada_b, 2048, mods + 4 * 8 * 3072);
    hipLaunchKernelGGL(k_rmsmod, dim3(T), dim3(256), 0, stream, x, ln_g, mods, hn);
    hipLaunchKernelGGL(k_gemm, dim3(16, T / 64), dim3(256), 0, stream, hn, D, s5_w_in, D, proj, D, T, D, D);
    hipLaunchKernelGGL(k_s5_prep, dim3(G), dim3(P), 0, stream, s5_lre, s5_lim, s5_logdt, s5_bre, s5_bim, s5a_re, s5a_im, s5bb_re, s5bb_im);
    hipLaunchKernelGGL(k_s5_scan, dim3(NB * G), dim3(P), 0, stream, proj, s5a_re, s5a_im, s5bb_re, s5bb_im, s5_cre, s5_cim, s5_d, hn);
    hipLaunchKernelGGL(k_gemm, dim3(32, T / 64), dim3(256), 0, stream, hn, D, s5_w_out, 2048, proj, 2048, T, 2048, D);
    hipLaunchKernelGGL(k_glu_res, dim3(T * D / 256), dim3(256), 0, stream, x, proj, mods, h);
    hipLaunchKernelGGL(k_rmsmod, dim3(T), dim3(256), 0, stream, h, ln_g + D, mods + 1 * 8 * 3072, hn);
    hipLaunchKernelGGL(k_route, dim3(T / 64), dim3(64), 0, stream, hn, moe_wg, moe_bg, moe_we, moe_be, eid, ew);
    hipLaunchKernelGGL(k_moe_up, dim3(T), dim3(256), 0, stream, hn, eid, moe_w1, moe_w3, proj);
    hipLaunchKernelGGL(k_moe_down, dim3(T), dim3(256), 0, stream, proj, eid, ew, moe_w2, mods + 1 * 8 * 3072, h, h);
    hipLaunchKernelGGL(k_rmsmod, dim3(T), dim3(256), 0, stream, h, kv_g, mods + 4 * 8 * 3072, hn);
    hipLaunchKernelGGL(k_gemm, dim3(33, T / 64), dim3(256), 0, stream, hn, D, kv_w, 2064, proj, 2064, T, 2064, D);
    unsigned short* Kb = (unsigned short*)hn; unsigned short* Vb = Kb + (size_t)T * D;
    hipLaunchKernelGGL(k_kvpost, dim3(T), dim3(256), 0, stream, proj, k_norm_g, kv_fb, Kb, Vb, logf);
    hipLaunchKernelGGL(k_cumsum, dim3(2), dim3(64), 0, stream, logf);
    float* hn2 = proj; float* qbuf = proj + (size_t)T * D;
    hipLaunchKernelGGL(k_rmsmod, dim3(T), dim3(256), 0, stream, h, ln_g + 2 * D, mods + 2 * 8 * 3072, hn2);
    hipLaunchKernelGGL(k_gemm, dim3(16, T / 64), dim3(256), 0, stream, hn2, D, fox_w_qg + 1024, 2048, qbuf, D, T, D, D);
    hipLaunchKernelGGL(k_sig_bf, dim3(T * D / 256), dim3(256), 0, stream, qbuf, Gb);
    hipLaunchKernelGGL(k_gemm, dim3(16, T / 64), dim3(256), 0, stream, hn2, D, fox_w_qg, 2048, qbuf, D, T, D, D);
    hipLaunchKernelGGL(k_qpost, dim3(T), dim3(256), 0, stream, qbuf, fox_qng);
    hipLaunchKernelGGL(k_attn, dim3(NB * H * (L / 64)), dim3(64), 0, stream, qbuf, Kb, Vb, logf, Gb);
    hipLaunchKernelGGL(k_gemm, dim3(16, T / 64), dim3(256), 0, stream, qbuf, D, fox_w_o, D, hn2, D, T, D, D);
    hipLaunchKernelGGL(k_res, dim3(T * D / 256), dim3(256), 0, stream, h, hn2, mods + 2 * 8 * 3072, h);
    hipLaunchKernelGGL(k_rmsmod, dim3(T), dim3(256), 0, stream, h, ln_g + 3 * D, mods + 3 * 8 * 3072, hn);
    hipLaunchKernelGGL(k_route, dim3(T / 64), dim3(64), 0, stream, hn, moe_wg + D * 4, moe_bg + 4, moe_we + D * 32, moe_be + 32, eid, ew);
    hipLaunchKernelGGL(k_moe_up, dim3(T), dim3(256), 0, stream, hn, eid, moe_w1 + (size_t)E * D * F, moe_w3 + (size_t)E * D * F, proj);
    hipLaunchKernelGGL(k_moe_down, dim3(T), dim3(256), 0, stream, proj, eid, ew, moe_w2 + (size_t)E * F * D, mods + 3 * 8 * 3072, h, h);
}
```

```cpp
#define ONE_LAUNCH 1
#include <hip/hip_runtime.h>
#include <hip/hip_bf16.h>
#include <cstdint>
#include <cstdio>
namespace attn_body {
using bf16=__hip_bfloat16;
using bf16x8=__attribute__((ext_vector_type(8)))short;
using s16x4=__attribute__((ext_vector_type(4)))short;
using f32x16=__attribute__((ext_vector_type(16)))float;
using u32x4=__attribute__((ext_vector_type(4)))unsigned;
constexpr int BATCH=8,NHEAD=16,SEQ=4096,D=64,DM=NHEAD*D;
constexpr int NW=8,QBLK=32,QB=QBLK*NW,KVBLK=64,NQB=SEQ/QB;
constexpr int ATTN_PITCH=DM, ATTN_UNIT_ROWS=QB;
__device__ __forceinline__ int crow(int r,int hi){return (r&3)+8*(r>>2)+4*hi;}
#define SBAR() __builtin_amdgcn_sched_barrier(0)
__device__ __forceinline__ void cmask(f32x16&p0,f32x16&p1,int jb,int qrel,int hi){
  const float NEG=-INFINITY; int kb=64*jb+4*hi;
  #pragma unroll
  for(int r=0;r<16;++r){int kv=kb+(r&3)+8*(r>>2); if(kv>qrel)p0[r]=NEG; if(kv+32>qrel)p1[r]=NEG;}
}

constexpr int NSLOT=3, SLOTB=8192;
constexpr int LDS_K=0, LDS_V=NSLOT*SLOTB, LDS_WS=2*NSLOT*SLOTB, LDS_OST=LDS_WS+NW*64*4, LDS_FL=LDS_OST+NW*4096, LDS_BYTES=LDS_FL+SEQ*4;
constexpr float C2=0.125f*1.4426950408889634f;
__device__ __forceinline__ void glds16s(const void*gbase,unsigned voff,unsigned lds_dst){unsigned keep;
  asm volatile("s_mov_b32 %0, m0\n\ts_mov_b32 m0, %3\n\ts_nop 0\n\tglobal_load_lds_dwordx4 %1, %2\n\ts_mov_b32 m0, %0":"=&s"(keep):"v"(voff),"s"(gbase),"s"(lds_dst):"memory");}
__device__ __forceinline__ void glds16(const void*gsrc,unsigned lds_dst){unsigned keep;
  asm volatile("s_mov_b32 %0, m0\n\ts_mov_b32 m0, %2\n\ts_nop 0\n\tglobal_load_lds_dwordx4 %1, off\n\ts_mov_b32 m0, %0":"=&s"(keep):"v"(gsrc),"s"(lds_dst):"memory");}
__device__ __forceinline__ float max3f(float a,float b,float c){float r;asm("v_max3_f32 %0, %1, %2, %3":"=v"(r):"v"(a),"v"(b),"v"(c));return r;}
__device__ __forceinline__ float max2f(float a,float b){float r;asm("v_max_f32_e32 %0, %1, %2":"=v"(r):"v"(a),"v"(b));return r;}
__device__ __forceinline__ float fadd_s(float a,float b){float r;asm("v_add_f32_e32 %0, %1, %2":"=v"(r):"v"(a),"v"(b));return r;}
__device__ __forceinline__ float fsub_s(float a,float b){float r;asm("v_sub_f32_e32 %0, %1, %2":"=v"(r):"v"(a),"v"(b));return r;}
typedef float f32x2_t __attribute__((ext_vector_type(2))); typedef float f32x4_t __attribute__((ext_vector_type(4))); typedef __bf16 bf16x2_t __attribute__((ext_vector_type(2)));
__device__ __forceinline__ unsigned cvtpk_s(float lo,float hi){f32x2_t v={lo,hi};bf16x2_t b=__builtin_convertvector(v,bf16x2_t);return __builtin_bit_cast(unsigned,b);}
#define WAIT_BAR(N) asm volatile("s_waitcnt vmcnt(" #N ") lgkmcnt(0)\n\ts_barrier":::"memory")

__device__ __forceinline__ void qkt(f32x16&p0,f32x16&p1,const char*Kslot,const bf16x8*qr,int r32,int hi){ const f32x16 negm={};
  const char*kb=Kslot+hi*1024+r32*16;
  #pragma unroll
  for(int d0=0;d0<4;++d0){
    const bf16x8 b0=*reinterpret_cast<const bf16x8*>(kb+d0*2048);
    const bf16x8 b1=*reinterpret_cast<const bf16x8*>(kb+d0*2048+512);
    if(d0==0){p0=__builtin_amdgcn_mfma_f32_32x32x16_bf16(b0,qr[0],negm,0,0,0);p1=__builtin_amdgcn_mfma_f32_32x32x16_bf16(b1,qr[0],negm,0,0,0);}
    else{p0=__builtin_amdgcn_mfma_f32_32x32x16_bf16(b0,qr[d0],p0,0,0,0);p1=__builtin_amdgcn_mfma_f32_32x32x16_bf16(b1,qr[d0],p1,0,0,0);}}
}
typedef __attribute__((address_space(3))) const char* lds_cptr;
typedef short v4i16_t __attribute__((ext_vector_type(4)));
__device__ __forceinline__ void kload8(bf16x8*kf,lds_cptr kp){
  kf[0]=*(const __attribute__((address_space(3))) bf16x8*)(kp);      kf[1]=*(const __attribute__((address_space(3))) bf16x8*)(kp+512);
  kf[2]=*(const __attribute__((address_space(3))) bf16x8*)(kp+2048); kf[3]=*(const __attribute__((address_space(3))) bf16x8*)(kp+2560);
  kf[4]=*(const __attribute__((address_space(3))) bf16x8*)(kp+4096); kf[5]=*(const __attribute__((address_space(3))) bf16x8*)(kp+4608);
  kf[6]=*(const __attribute__((address_space(3))) bf16x8*)(kp+6144); kf[7]=*(const __attribute__((address_space(3))) bf16x8*)(kp+6656);
}
__device__ __forceinline__ void kload2(bf16x8*kf,lds_cptr kp,int j){ kf[2*j]=*(const __attribute__((address_space(3))) bf16x8*)(kp+j*2048); kf[2*j+1]=*(const __attribute__((address_space(3))) bf16x8*)(kp+j*2048+512); }
__device__ __forceinline__ s16x4 vtr(lds_cptr p){ return __builtin_bit_cast(s16x4,__builtin_amdgcn_ds_read_tr16_b64_v4i16((__attribute__((address_space(3))) v4i16_t*)p)); }
__device__ __forceinline__ float rowmax(const f32x16&p0,const f32x16&p1){
  float a=max3f(p0[0],p0[1],p1[0]),b=max3f(p0[2],p0[3],p1[1]);a=max3f(a,p1[2],p1[3]);
  #pragma unroll
  for(int r=4;r<16;r+=4){a=max3f(a,p0[r],p0[r+1]);b=max3f(b,p0[r+2],p0[r+3]);a=max3f(a,p1[r],p1[r+1]);b=max3f(b,p1[r+2],p1[r+3]);}
  const float m=max2f(a,b);
  auto rr=__builtin_amdgcn_permlane32_swap(__float_as_uint(m),__float_as_uint(m),false,false);
  return max2f(__uint_as_float(rr[0]),__uint_as_float(rr[1]));
}
__device__ __forceinline__ void pv(f32x16*o,int vb,bf16x8 pa0,bf16x8 pa1,bf16x8 pa2,bf16x8 pa3){
  #pragma unroll
  for(int d0=0;d0<2;++d0){s16x4 lo[4],hi[4];
    #pragma unroll
    for(int ks=0;ks<4;++ks){
      asm volatile("ds_read_b64_tr_b16 %0,%1 offset:%c2":"=&v"(lo[ks]):"v"(vb),"i"(d0*4096+ks*1024):"memory");
      asm volatile("ds_read_b64_tr_b16 %0,%1 offset:%c2":"=&v"(hi[ks]):"v"(vb),"i"(d0*4096+ks*1024+512):"memory");}
    asm volatile("s_waitcnt lgkmcnt(0)":::"memory");SBAR();
    #define PK(k) (bf16x8){lo[k][0],lo[k][1],lo[k][2],lo[k][3],hi[k][0],hi[k][1],hi[k][2],hi[k][3]}
    o[d0]=__builtin_amdgcn_mfma_f32_32x32x16_bf16(pa0,PK(0),o[d0],0,0,0);
    o[d0]=__builtin_amdgcn_mfma_f32_32x32x16_bf16(pa1,PK(1),o[d0],0,0,0);
    o[d0]=__builtin_amdgcn_mfma_f32_32x32x16_bf16(pa2,PK(2),o[d0],0,0,0);
    o[d0]=__builtin_amdgcn_mfma_f32_32x32x16_bf16(pa3,PK(3),o[d0],0,0,0);
    #undef PK
  }
}

#ifndef ATTN_STORE16
#define ATTN_STORE16(p,v) (*(u32x4*)(p)=(v))
#endif
template<int THRL> __device__ __forceinline__ void attn_unit(int b,int h,int qb,const bf16*Q,const bf16*__restrict__ K,const bf16*__restrict__ V,bf16*O,const bf16*__restrict__ Gt,char*shm){
  int tid=threadIdx.x; asm volatile("":"+v"(tid)); const int lane=tid&63,r32=lane&31,hi=lane>>5; const int wid=__builtin_amdgcn_readfirstlane(tid>>6);
  const long rowbase=(long)b*SEQ; const int q0=qb*QB;
  const bf16*Qw=Q+(rowbase+q0+wid*QBLK)*DM+h*D;
  const bf16*Kh=K+rowbase*DM+h*D,*Vh=V+rowbase*DM+h*D;
  const unsigned lds0=(unsigned)(uintptr_t)shm;
  float*wsf=(float*)(shm+LDS_WS)+wid*64;
  const unsigned koff=(unsigned)((lane*DM+wid*8)*2);
  const unsigned voff=(unsigned)(((16*(wid&3)+(lane>>2))*DM+(wid>>2)*32+(lane&3)*8)*2);
  const unsigned kdst=lds0+LDS_K+wid*1024, vdst=lds0+LDS_V+wid*1024;
  #define DMA_K(t,slot) glds16s(Kh,koff+(unsigned)(t)*(unsigned)(KVBLK*DM*2),(unsigned)__builtin_amdgcn_readfirstlane(kdst+(slot)))
  #define DMA_V(t,slot) glds16s(Vh,voff+(unsigned)(t)*(unsigned)(KVBLK*DM*2),(unsigned)__builtin_amdgcn_readfirstlane(vdst+(slot)))
  const int vb0=(int)(lds0+LDS_V)+((lane>>4)&1)*32+(lane&3)*8+(4*hi+((lane&15)>>2))*64;
  const char*Kbase=shm+LDS_K; bf16x8 kf[8];
  const lds_cptr shm3=(lds_cptr)shm; const lds_cptr kp0=shm3+LDS_K+hi*1024+r32*16; const lds_cptr vp0=shm3+LDS_V+((lane>>4)&1)*32+(lane&3)*8+(4*hi+((lane&15)>>2))*64;
  const int NT=(q0+QB)/KVBLK;
  DMA_K(0,0);DMA_V(0,0);DMA_K(1,SLOTB);
  bf16x8 qr[4];
  #pragma unroll
  for(int d0=0;d0<4;++d0)qr[d0]=*reinterpret_cast<const bf16x8*>(&Qw[(long)r32*DM+d0*16+hi*8]);
  float mhat=0.f,l_reg=0.f;f32x16 o[2];o[0]=f32x16{};o[1]=f32x16{};const f32x16 negm={};
  const int qrel=wid*QBLK+r32;
  #define CMASK(P0,P1,t) do{int jb_=(t)-(NT-4); if(jb_>=0)cmask(P0,P1,jb_,qrel,hi);}while(0)
  const lds_cptr flp=(lds_cptr)shm+LDS_FL+hi*16;
  #define FBIAS(P0,P1,t) do{ const lds_cptr fp_=flp+(t)*256; const float nm_=-mhat; _Pragma("unroll") for(int g_=0;g_<4;++g_){ \
      { const f32x4_t b0_=*(const __attribute__((address_space(3))) f32x4_t*)(fp_+g_*32); P0[4*g_]+=b0_[0]+nm_;P0[4*g_+1]+=b0_[1]+nm_;P0[4*g_+2]+=b0_[2]+nm_;P0[4*g_+3]+=b0_[3]+nm_; } SBAR(); \
      { const f32x4_t b1_=*(const __attribute__((address_space(3))) f32x4_t*)(fp_+g_*32+128); P1[4*g_]+=b1_[0]+nm_;P1[4*g_+1]+=b1_[1]+nm_;P1[4*g_+2]+=b1_[2]+nm_;P1[4*g_+3]+=b1_[3]+nm_; } SBAR(); } }while(0)
  bool resc=false;
  #define START(P0,P1) do{ const float rm=rowmax(P0,P1); resc=false; \
    { const float dl=rm; mhat=fadd_s(mhat,dl); \
      _Pragma("unroll") for(int r=0;r<16;++r){P0[r]=fsub_s(P0[r],dl);P1[r]=fsub_s(P1[r],dl);} \
      } \
    _Pragma("unroll") for(int r=0;r<16;++r)P0[r]=__builtin_amdgcn_exp2f(P0[r]); }while(0)
  #define RESC() do{ if(resc){ asm volatile("s_waitcnt lgkmcnt(0)":::"memory"); \
      _Pragma("unroll") for(int d_=0;d_<2;++d_) _Pragma("unroll") for(int r=0;r<16;++r)o[d_][r]*=wsf[crow(r,hi)]; } }while(0)
  f32x16 pA0,pA1,pB0,pB1;
  int sl_prev=0,sl_cur=0,sl_next=SLOTB;
  #define ROT() do{sl_prev=sl_cur;sl_cur=sl_next;sl_next=(sl_next==(NSLOT-1)*SLOTB)?0:sl_next+SLOTB;}while(0)
  DMA_K(2,2*SLOTB);
  WAIT_BAR(3);
  qkt(pA0,pA1,Kbase,qr,r32,hi);asm volatile("s_nop 15\n\ts_nop 7":"+v"(pA0),"+v"(pA1));FBIAS(pA0,pA1,0);CMASK(pA0,pA1,0);
  START(pA0,pA1);
  _Pragma("unroll") for(int r=0;r<16;++r)pA1[r]=__builtin_amdgcn_exp2f(pA1[r]);
  WAIT_BAR(0);
  DMA_K(3,0);DMA_V(1,SLOTB);
  ROT();
  kload8(kf,kp0+sl_cur);
  WAIT_BAR(2);
  s16x4 vlo[8],vhi[8]; u32x4 pw0,pw1,pw2,pw3;
  #define PKW(P,B) cvtpk_s(P[B],P[B+1])
  #define PAF(k) __builtin_bit_cast(bf16x8,pw##k)
  #define VFR(i) (bf16x8){vlo[i][0],vlo[i][1],vlo[i][2],vlo[i][3],vhi[i][0],vhi[i][1],vhi[i][2],vhi[i][3]}
  #define PIN(x) asm volatile("":"+v"(x))
  #define MX3(a,b,c) __builtin_fmaxf(__builtin_fmaxf((a),(b)),(c))
  #define GAPA(MF,A0,A1,A2,A3,W0,W1,PW) do{ MF; sacc+=A0; sacc+=A1; sacc+=A2; sacc+=A3; PIN(sacc); W0; W1; PIN(PW); SBAR(); }while(0)
  #define EX(v) __builtin_amdgcn_exp2f(v)
  #define GAPB(MF,X,B) do{ MF; X[B]=EX(X[B]); X[B+1]=EX(X[B+1]); X[B+2]=EX(X[B+2]); X[B+3]=EX(X[B+3]); PIN(X); SBAR(); }while(0)
  #define VRD(i) do{ vlo[i]=vtr(vp_+(((i)>>2)*4096+((i)&3)*1024)); vhi[i]=vtr(vp_+(((i)>>2)*4096+((i)&3)*1024+512)); }while(0)
  #define KRD(G,j) do{ if(G){ kload2(kf,kp0+sl_next,j); SBAR(); } }while(0)
  #define STEP(C0,C1,P0,P1,t,GK,GV,GL) do{ SBAR(); \
    const lds_cptr vp_=vp0+sl_prev; \
    VRD(0); SBAR(); float sacc=(P0[0]+P0[1]); \
    GAPA(C0=__builtin_amdgcn_mfma_f32_32x32x16_bf16(kf[0],qr[0],negm,0,0,0), P0[2],P0[3],P0[4],P0[5],     pw0[0]=PKW(P0,0), pw0[1]=PKW(P0,2), pw0); \
    VRD(4); SBAR(); GAPA(C1=__builtin_amdgcn_mfma_f32_32x32x16_bf16(kf[1],qr[0],negm,0,0,0), P0[6],P0[7],P0[8],P0[9],     pw0[2]=PKW(P0,4), pw0[3]=PKW(P0,6), pw0); \
    VRD(1); SBAR(); GAPA(C0=__builtin_amdgcn_mfma_f32_32x32x16_bf16(kf[2],qr[1],C0,0,0,0),   P0[10],P0[11],P0[12],P0[13], pw1[0]=PKW(P0,8), pw1[1]=PKW(P0,10), pw1); \
    VRD(5); SBAR(); GAPA(C1=__builtin_amdgcn_mfma_f32_32x32x16_bf16(kf[3],qr[1],C1,0,0,0),   P0[14],P0[15],P1[0],P1[1],   pw1[2]=PKW(P0,12),pw1[3]=PKW(P0,14), pw1); \
    VRD(2); SBAR(); GAPA(C0=__builtin_amdgcn_mfma_f32_32x32x16_bf16(kf[4],qr[2],C0,0,0,0),   P1[2],P1[3],P1[4],P1[5],     pw2[0]=PKW(P1,0), pw2[1]=PKW(P1,2), pw2); \
    VRD(6); SBAR(); GAPA(C1=__builtin_amdgcn_mfma_f32_32x32x16_bf16(kf[5],qr[2],C1,0,0,0),   P1[6],P1[7],P1[8],P1[9],     pw2[2]=PKW(P1,4), pw2[3]=PKW(P1,6), pw2); \
    VRD(3); SBAR(); GAPA(C0=__builtin_amdgcn_mfma_f32_32x32x16_bf16(kf[6],qr[3],C0,0,0,0),   P1[10],P1[11],P1[12],P1[13], pw3[0]=PKW(P1,8), pw3[1]=PKW(P1,10), pw3); \
    VRD(7); SBAR(); GAPA(C1=__builtin_amdgcn_mfma_f32_32x32x16_bf16(kf[7],qr[3],C1,0,0,0),   P1[14],P1[15],0.f,0.f,       pw3[2]=PKW(P1,12),pw3[3]=PKW(P1,14), pw3); \
    l_reg+=sacc; \
    if(GK){DMA_K((t)+3,sl_cur);} if(GV){DMA_V((t)+1,sl_next);} \
    FBIAS(C0,C1,t); CMASK(C0,C1,t); \
    { float a=MX3(C0[0],C0[1],C1[0]),b=MX3(C0[2],C0[3],C1[1]); a=MX3(a,C1[2],C1[3]); \
      _Pragma("unroll") for(int r=4;r<16;r+=4){a=MX3(a,C0[r],C0[r+1]);b=MX3(b,C0[r+2],C0[r+3]);a=MX3(a,C1[r],C1[r+1]);b=MX3(b,C1[r+2],C1[r+3]);} \
      float rm=__builtin_fmaxf(a,b); { auto rr=__builtin_amdgcn_permlane32_swap(__float_as_uint(rm),__float_as_uint(rm),false,false); rm=__builtin_fmaxf(__uint_as_float(rr[0]),__uint_as_float(rr[1])); } \
      resc=false; \
      if(__builtin_expect(__any(rm>(float)THRL),0)){ const float dl=__builtin_fmaxf(rm,0.f); mhat+=dl; \
        _Pragma("unroll") for(int r=0;r<16;++r){C0[r]-=dl;C1[r]-=dl;} \
        const float f=__builtin_amdgcn_exp2f(-dl); l_reg*=f; if(hi==0)wsf[r32]=f; resc=true; } } \
    SBAR(); \
    GAPB(o[0]=__builtin_amdgcn_mfma_f32_32x32x16_bf16(PAF(0),VFR(0),o[0],0,0,0), C0,0); \
    GAPB(o[1]=__builtin_amdgcn_mfma_f32_32x32x16_bf16(PAF(0),VFR(4),o[1],0,0,0), C0,4); \
    KRD(GL,0); GAPB(o[0]=__builtin_amdgcn_mfma_f32_32x32x16_bf16(PAF(1),VFR(1),o[0],0,0,0), C0,8); \
    KRD(GL,1); GAPB(o[1]=__builtin_amdgcn_mfma_f32_32x32x16_bf16(PAF(1),VFR(5),o[1],0,0,0), C0,12); \
    KRD(GL,2); GAPB(o[0]=__builtin_amdgcn_mfma_f32_32x32x16_bf16(PAF(2),VFR(2),o[0],0,0,0), C1,0); \
    KRD(GL,3); GAPB(o[1]=__builtin_amdgcn_mfma_f32_32x32x16_bf16(PAF(2),VFR(6),o[1],0,0,0), C1,4); \
    GAPB(o[0]=__builtin_amdgcn_mfma_f32_32x32x16_bf16(PAF(3),VFR(3),o[0],0,0,0), C1,8); \
    GAPB(o[1]=__builtin_amdgcn_mfma_f32_32x32x16_bf16(PAF(3),VFR(7),o[1],0,0,0), C1,12); \
    }while(0)
  int t=1;
  #undef CMASK
  #define CMASK(P0,P1,t) do{}while(0)
  for(;t+5<NT;t+=2){
    STEP(pB0,pB1,pA0,pA1,t,true,true,true);     WAIT_BAR(2); RESC(); ROT();
    STEP(pA0,pA1,pB0,pB1,t+1,true,true,true);   WAIT_BAR(2); RESC(); ROT();
  }
  #undef CMASK
  #define CMASK(P0,P1,t) do{int jb_=(t)-(NT-4); if(jb_>=0)cmask(P0,P1,jb_,qrel,hi);}while(0)
  #define ENDW(tt) do{ if((tt)+3<NT){WAIT_BAR(2);} else if((tt)+2<NT){WAIT_BAR(1);} else {WAIT_BAR(0);} }while(0)
  for(;t+1<NT;t+=2){
    STEP(pB0,pB1,pA0,pA1,t,(t+3<NT),(t+1<NT),(t+1<NT));       ENDW(t);   RESC(); ROT();
    STEP(pA0,pA1,pB0,pB1,t+1,(t+4<NT),(t+2<NT),(t+2<NT));     ENDW(t+1); RESC(); ROT();
  }
  STEP(pB0,pB1,pA0,pA1,NT-1,false,false,false); RESC();
  { float sacc=pB0[0]+pB0[1]; _Pragma("unroll") for(int r=2;r<16;++r)sacc+=pB0[r]; _Pragma("unroll") for(int r=0;r<16;++r)sacc+=pB1[r]; l_reg+=sacc;
    pw0=(u32x4){PKW(pB0,0),PKW(pB0,2),PKW(pB0,4),PKW(pB0,6)};pw1=(u32x4){PKW(pB0,8),PKW(pB0,10),PKW(pB0,12),PKW(pB0,14)};pw2=(u32x4){PKW(pB1,0),PKW(pB1,2),PKW(pB1,4),PKW(pB1,6)};pw3=(u32x4){PKW(pB1,8),PKW(pB1,10),PKW(pB1,12),PKW(pB1,14)};
    SBAR(); pv(o,vb0+sl_cur,PAF(0),PAF(1),PAF(2),PAF(3)); }
  #undef PKW
  #undef PAF
  #undef VFR
  #undef PIN
  #undef MX3
  #undef GAPA
  #undef GAPB
  #undef EX
  #undef VRD
  #undef KRD
  #undef STEP
  #undef ENDW
  {auto rr=__builtin_amdgcn_permlane32_swap(__float_as_uint(l_reg),__float_as_uint(l_reg),false,false);l_reg=__uint_as_float(rr[0])+__uint_as_float(rr[1]);}
  if(hi==0)wsf[32+r32]=l_reg;asm volatile("s_waitcnt lgkmcnt(0)":::"memory");
  float rli[16];
  #pragma unroll
  for(int r=0;r<16;++r)rli[r]=__builtin_amdgcn_rcpf(wsf[32+crow(r,hi)]);
  bf16*Ow=O+(rowbase+q0+wid*QBLK)*DM+h*D;
  { bf16*stg=(bf16*)(shm+LDS_OST)+wid*2048;
    #pragma unroll
    for(int r=0;r<16;++r){const int orow=crow(r,hi);
      #pragma unroll
      for(int d0=0;d0<2;++d0)stg[orow*64+d0*32+r32]=__float2bfloat16(o[d0][r]*rli[r]);}
    asm volatile("s_waitcnt lgkmcnt(0)":::"memory");
    const bf16*Gw=Gt+(rowbase+q0+wid*QBLK)*DM+h*D;
    #pragma unroll
    for(int i=0;i<4;++i){const int row=i*8+(lane>>3),ch=lane&7; const u32x4 v=*(const u32x4*)(stg+row*64+ch*8); const u32x4 gg=*(const u32x4*)(Gw+(long)row*DM+ch*8); u32x4 w;
      w.x=cvtpk_s(__builtin_bit_cast(float,v.x<<16)*__builtin_bit_cast(float,gg.x<<16),__builtin_bit_cast(float,v.x&0xffff0000u)*__builtin_bit_cast(float,gg.x&0xffff0000u));
      w.y=cvtpk_s(__builtin_bit_cast(float,v.y<<16)*__builtin_bit_cast(float,gg.y<<16),__builtin_bit_cast(float,v.y&0xffff0000u)*__builtin_bit_cast(float,gg.y&0xffff0000u));
      w.z=cvtpk_s(__builtin_bit_cast(float,v.z<<16)*__builtin_bit_cast(float,gg.z<<16),__builtin_bit_cast(float,v.z&0xffff0000u)*__builtin_bit_cast(float,gg.z&0xffff0000u));
      w.w=cvtpk_s(__builtin_bit_cast(float,v.w<<16)*__builtin_bit_cast(float,gg.w<<16),__builtin_bit_cast(float,v.w&0xffff0000u)*__builtin_bit_cast(float,gg.w&0xffff0000u));
      ATTN_STORE16(Ow+(long)row*DM+ch*8,w);} }
  asm volatile("s_waitcnt lgkmcnt(0)\n\ts_barrier":::"memory");
  #undef DMA_K
  #undef DMA_V
  #undef CMASK
  #undef FBIAS
  #undef START
  #undef RESC
  #undef ROT
}
constexpr int ATTN_LDS_BYTES=LDS_BYTES;
struct AttnTensors { const bf16* Q; const bf16* K; const bf16* V; bf16* O; const bf16* G; const float* logf; };
struct AttnUnit { int bh; int qb; };
struct StaticOrder {
  int vcu, G;
  __device__ __forceinline__ explicit StaticOrder(int grid,int v):vcu(v),G(grid){}
  __device__ __forceinline__ bool next(int i,AttnUnit&u)const{
    if(G==256){ if(i>=8)return false; const int s=(vcu&1)*4+(i>>1); u.bh=vcu>>1; u.qb=(i&1)?15-s:s; return true; }
    const int U=i*G+vcu; if(U>=BATCH*NHEAD*NQB)return false; u.bh=U/NQB; u.qb=U%NQB; return true; }
};
__device__ __forceinline__ void build_forget_table(char*lds,const float*logf_bh){
  const int tid=threadIdx.x,lane=tid&63,wid=tid>>6; float*fl=(float*)(lds+LDS_FL); float*ws=(float*)(lds+LDS_WS);
  float v[8]; float run=0.f; int toff=tid*8; asm volatile("":"+v"(toff));
  #pragma unroll
  for(int j=0;j<8;++j){ run+=logf_bh[toff+j]; v[j]=run; }
  float inc=run;
  #pragma unroll
  for(int o=1;o<64;o<<=1){ const float x=__shfl_up(inc,o); if(lane>=o)inc+=x; }
  if(lane==63)ws[wid]=inc;
  __syncthreads();
  float base=inc-run;
  for(int w=0;w<wid;++w)base+=ws[w];
  #pragma unroll
  for(int j=0;j<8;++j)fl[tid*8+j]=-(base+v[j])*1.4426950408889634f;
  __syncthreads();
}
template<class Sched,int THRL=8> __device__ __forceinline__ void attn_phase(char*lds,const AttnTensors&T,const Sched&S){
  AttnUnit u; int cur_bh=-1;
  for(int i=0;S.next(i,u);++i){
    if(u.bh!=cur_bh){ build_forget_table(lds,T.logf+(size_t)u.bh*SEQ); cur_bh=u.bh; }
    attn_unit<THRL>(u.bh/NHEAD,u.bh%NHEAD,u.qb,T.Q,T.K,T.V,T.O,T.G,lds); }
}
#undef SBAR
#undef WAIT_BAR
}
namespace mk {
#define LAS __attribute__((address_space(3)))
#define GAS __attribute__((address_space(1)))
typedef unsigned short bf16_t;
typedef short bf16x8 __attribute__((ext_vector_type(8)));
typedef float f32x4 __attribute__((ext_vector_type(4)));
typedef float f32x2 __attribute__((ext_vector_type(2)));
typedef unsigned u32x4 __attribute__((ext_vector_type(4)));
typedef unsigned u32x2 __attribute__((ext_vector_type(2)));
constexpr int NWAVES = 8, NTHR = 512;
constexpr int D = 1024, NB = 8, L = 4096, T = NB * L, G = 64, P = 64, GC = 16, H = 16, HD = 64, NE = 32, FH = 256;
constexpr float EPS = 1e-6f;
constexpr float C2Q = 0.125f * 1.4426950408889634f;

constexpr size_t MiB = 1u << 20;
constexpr size_t WS_CTL = 0, CTL_ZERO_BYTES = 1 * MiB;
constexpr size_t WS_MODS = 1 * MiB;
constexpr size_t WS_LOGF = 2 * MiB;
constexpr size_t WS_EW = 4 * MiB;
constexpr size_t WS_EID = 4 * MiB + 512 * 1024;
constexpr size_t WS_LIST = 5 * MiB;
constexpr size_t WS_A64 = 9 * MiB;
constexpr size_t WS_BT_IN = 10 * MiB, WS_BT_OUT = 12 * MiB, WS_BT_KV = 16 * MiB, WS_BT_FZ = 20 * MiB, WS_BT_R = 20 * MiB + 512 * 1024;
constexpr size_t WS_BT_QG = 22 * MiB, WS_BT_O = 26 * MiB, WS_BT1 = 28 * MiB, WS_BT2 = 92 * MiB;
constexpr size_t WS_SLOT0 = 124 * MiB, SLOT = 64 * MiB;
constexpr size_t WS_END = WS_SLOT0 + 6 * SLOT;
#define SLOTP(i) (WS_SLOT0 + (size_t)(i) * SLOT)
constexpr size_t WS_KTAB = SLOTP(5), WS_WB = SLOTP(5) + 8 * MiB, WS_VT = SLOTP(5) + 24 * MiB;
constexpr int KTAB_G = 127 * 256;
constexpr int CW_TMO = 0, CW_CNT = 64  , CW_BAR = 4096;

constexpr int RING_BYTES = 131072, LDS_IDX_OFF = RING_BYTES  , LDSCTL_OFF = RING_BYTES + 2048, MISC_OFF = LDSCTL_OFF + 320;
constexpr int LDS_BYTES = 147456;

__device__ __forceinline__ unsigned f2bf(float f) { unsigned u = __builtin_bit_cast(unsigned, f); return (u + 0x7fffu + ((u >> 16) & 1u)) >> 16; }
__device__ __forceinline__ unsigned pk2(float lo, float hi) { typedef float v2f __attribute__((ext_vector_type(2))); typedef __bf16 v2b __attribute__((ext_vector_type(2))); v2f v = {lo, hi}; v2b b = __builtin_convertvector(v, v2b); return __builtin_bit_cast(unsigned, b); }
__device__ __forceinline__ float bflo(unsigned w) { return __builtin_bit_cast(float, w << 16); }
__device__ __forceinline__ float bfhi(unsigned w) { return __builtin_bit_cast(float, w & 0xffff0000u); }
__device__ __forceinline__ float fast_sigmoid(float x) { return __builtin_amdgcn_rcpf(1.0f + __builtin_amdgcn_exp2f(-1.4426950408889634f * x)); }
__device__ __forceinline__ float fast_silu(float x) { return x * fast_sigmoid(x); }
__device__ __forceinline__ float fast_gelu_tanh(float x) { const float z = 0.7978845608028654f * (x + 0.044715f * x * x * x); return x * fast_sigmoid(2.0f * z); }
__device__ __forceinline__ float wave_sum(float v) {
#pragma unroll
    for (int o = 1; o < 64; o <<= 1) v += __shfl_xor(v, o);
    return v;
}
#define LDS_WAIT() asm volatile("s_waitcnt lgkmcnt(0)" ::: "memory")
#define VM_WAIT() asm volatile("s_waitcnt vmcnt(0)" ::: "memory")

#define XB_TMO      128
#define XB_XCNT(j)  (256  + 64 * (j))
#define XB_XSUB(j)  (1280 + 64 * (j))
#define XB_XGEN(j)  (2304 + 64 * (j))
#define XB_TOP      3328
#define XB_TOPGEN   3392
#define XCD_BAR_WORDS 3456
#define XB_SPIN_CAP (1u << 18)
__device__ __forceinline__ unsigned xb_ld(unsigned* p)              { return __hip_atomic_load(p, __ATOMIC_RELAXED, __HIP_MEMORY_SCOPE_AGENT); }
__device__ __forceinline__ unsigned xb_add(unsigned* p, unsigned v) { return __hip_atomic_fetch_add(p, v, __ATOMIC_RELAXED, __HIP_MEMORY_SCOPE_AGENT); }
__device__ __forceinline__ unsigned xb_xcc_id() { return (unsigned)__builtin_amdgcn_s_getreg((3 << 11) | 20) & 0xFu; }
#define XB_SPIN(cond, bar) do { unsigned _sp = 0; while (cond) { __builtin_amdgcn_s_sleep(1); \
    if ((++_sp & 255u) == 0u) { if (xb_ld(&(bar)[XB_TMO])) break; if (_sp > XB_SPIN_CAP) { atomicAdd(&(bar)[XB_TMO], 1u); break; } } } } while (0)
struct XcdBarrier { unsigned* bar; unsigned x; volatile LAS unsigned* st; };
__device__ __forceinline__ XcdBarrier xcd_barrier_post(unsigned* bar, volatile LAS unsigned* st) {
    XcdBarrier b; b.bar = bar; b.x = xb_xcc_id(); b.st = st;
    if (threadIdx.x == 0) (void)xb_add(&bar[XB_XCNT(b.x)], 1u);
    return b;
}
__device__ __forceinline__ void xcd_barrier_complete(unsigned* bar, unsigned x, unsigned& nloc, unsigned& nx) {
    const unsigned Gd = gridDim.x * gridDim.y * gridDim.z;
    unsigned sum, cnt, mine, sp = 0u;
    for (;;) {
        sum = 0u; cnt = 0u; mine = 0u;
#pragma unroll
        for (unsigned j = 0; j < 16; ++j) { const unsigned c = xb_ld(&bar[XB_XCNT(j)]); sum += c; cnt += (c > 0u) ? 1u : 0u; mine = (j == x) ? c : mine; }
        if (sum == Gd) break;
        __builtin_amdgcn_s_sleep(1);
        if ((++sp & 255u) == 0u) { if (xb_ld(&bar[XB_TMO])) break; if (sp > XB_SPIN_CAP) { atomicAdd(&bar[XB_TMO], 1u); break; } }
    }
    nloc = mine > 0u ? mine : 1u; nx = cnt > 0u ? cnt : 1u;
}
__device__ __forceinline__ void xcd_barrier(const XcdBarrier& b) {
    asm volatile("s_waitcnt vmcnt(0)" ::: "memory");
    __syncthreads();
    if (threadIdx.x == 0) {
        unsigned* bar = b.bar;
        __builtin_amdgcn_s_waitcnt(0);
        unsigned nloc = b.st[0], nx = b.st[1];
        if (nloc == 0u) { xcd_barrier_complete(bar, b.x, nloc, nx); b.st[0] = nloc; b.st[1] = nx; }
        const unsigned old = xb_add(&bar[XB_XSUB(b.x)], 1u);
        const unsigned gen = old / nloc;
        if (old + 1u == (gen + 1u) * nloc) {
            __builtin_amdgcn_fence(__ATOMIC_RELEASE, "agent");
            asm volatile("s_waitcnt vmcnt(0)" ::: "memory");
            const unsigned og = xb_add(&bar[XB_TOP], 1u);
            const unsigned tg = og / nx;
            if (og + 1u == (tg + 1u) * nx) xb_add(&bar[XB_TOPGEN], 1u);
            else XB_SPIN(xb_ld(&bar[XB_TOPGEN]) == tg, bar);
            __builtin_amdgcn_fence(__ATOMIC_ACQUIRE, "agent");
            xb_add(&bar[XB_XGEN(b.x)], 1u);
            asm volatile("s_waitcnt vmcnt(0)" ::: "memory");
        } else {
            XB_SPIN(xb_ld(&bar[XB_XGEN(b.x)]) == gen, bar);
            __builtin_amdgcn_fence(__ATOMIC_ACQUIRE, "agent");
            asm volatile("s_waitcnt vmcnt(0)" ::: "memory");
        }
    }
    __syncthreads();
}

struct Args { const float* in[31]; float* out; unsigned char* ws; int ph_lo, ph_hi; };
struct Frame {
    LAS unsigned char* lds; unsigned char* ws; const float* const* in; float* out;
    int tid, lane, wave, vcu, G;
};
enum In { I_X = 0, I_C, I_LNG, I_ADAW, I_ADAB, I_WIN, I_LRE, I_LIM, I_LOGDT, I_BRE, I_BIM, I_CRE, I_CIM, I_DSK, I_WOUT, I_KVG, I_KVADAW, I_KVADAB, I_KVW, I_KVFB, I_KNG,
          I_WQG, I_QNG, I_WO, I_MWG, I_MBG, I_MWE, I_MBE, I_MW1, I_MW3, I_MW2 };

namespace pg {
constexpr int BM = 256, BK = 64, HALF = 128, HTB = HALF * BK * 2, STAGE_BYTES = 8 * HTB, NXCD = 8, WGM = 8;
__host__ __device__ __forceinline__ int lds_byte(int r, int c) { const int st = (r >> 4) * 2 + (c >> 5), rr = r & 15, cc = c & 31, ob = rr * 64 + cc * 2; return st * 1024 + (ob ^ (((ob >> 9) & 1) << 5)); }
__host__ __device__ __forceinline__ void stage_rc(int b, int& R, int& C) { const int st = b / 1024, sb = b % 1024, swz = sb ^ (((sb >> 9) & 1) << 5); R = (st >> 1) * 16 + swz / 64; C = (st & 1) * 32 + (swz % 64) / 2; }
__host__ __device__ __forceinline__ int perm32(int rho) { const int n = rho >> 4, i = rho & 15; return 8 * (i >> 2) + 4 * n + (i & 3); }

struct GUnit {
    const char* a0; const char* a1; const char* b0; const char* b1; int nt;
    const char* xa0; const char* xa1; const char* xb0; const char* xb1; int nt2;
    const int* rows; int nrows;
    int i0, i1, i2, i3;
};
struct KStep { long a, b, a2, b2; };
struct DenseOrder {
    int nM, nN, nwg, Gd, c;
    __device__ void init(int M, int N, int G_, int c_) { nM = M / BM; nN = N / BM; nwg = nM * nN; Gd = G_; c = c_; }
    __device__ bool next(int i, int& pm, int& pn) const {
        const long Li = (long)i * Gd + c; if (Li >= nwg) return false;
        int wgid = (int)Li; { const int q = nwg / NXCD, r = nwg % NXCD, xcd = wgid % NXCD, off = wgid / NXCD; wgid = (xcd < r ? xcd * (q + 1) : r * (q + 1) + (xcd - r) * q) + off; }
        const int nig = WGM * nN, gid = wgid / nig, fm = gid * WGM, gsz = (nM - fm) < WGM ? (nM - fm) : WGM;
        pm = fm + ((wgid % nig) % gsz); pn = (wgid % nig) / gsz; return true;
    }
};
__device__ __forceinline__ unsigned cvt_pk_bf16(float lo, float hi) { unsigned r; asm volatile("v_cvt_pk_bf16_f32 %0, %1, %2" : "=v"(r) : "v"(lo), "v"(hi)); return r; }

struct LaneOff { int a[2], b[2], a2[2], b2[2]; };
template <class Epi, class Sched, bool SEG2, bool GATHER, bool ALIGN_EPI>
__device__ __forceinline__ void gemm_phase(LAS unsigned char* lds, const Sched& S, const Epi& E, const KStep ks, const LaneOff lo, const int gpitch) {
    int tid = threadIdx.x; asm volatile("" : "+v"(tid));
    const int wid = __builtin_amdgcn_readfirstlane(tid >> 6), lane = tid & 63, wr = wid >> 2, wc = wid & 3, fr = lane & 15, fq = lane >> 4;
    const unsigned ldsw = (unsigned)wid * 1024u;
    const int aoff = lds_byte(wr * 64 + fr, fq * 8), boff = lds_byte(wc * 32 + fr, fq * 8);
#define PG_SA(b, h) (((b) * 2 + (h)) * HTB)
#define PG_SB(b, h) ((4 + (b) * 2 + (h)) * HTB)
#define PG_STAGE(bufoff, gbase, v0, v1) do { \
        __builtin_amdgcn_global_load_lds((const unsigned*)((const char*)(gbase) + (long)(v0)), (LAS unsigned*)(lds + (bufoff) + ldsw), 16, 0, 0); \
        __builtin_amdgcn_global_load_lds((const unsigned*)((const char*)(gbase) + (long)(v1)), (LAS unsigned*)(lds + (bufoff) + ldsw + 8192), 16, 0, 0); } while (0)
#define PG_LDA(dst, b, h) do { _Pragma("unroll") for (int m = 0; m < 4; ++m) _Pragma("unroll") for (int k = 0; k < 2; ++k) dst[m][k] = *(const LAS bf16x8*)(lds + PG_SA(b, h) + aoff + m * 2048 + k * 1024); } while (0)
#define PG_LDB(dst, b, h) do { _Pragma("unroll") for (int n = 0; n < 2; ++n) _Pragma("unroll") for (int k = 0; k < 2; ++k) dst[n][k] = *(const LAS bf16x8*)(lds + PG_SB(b, h) + boff + n * 2048 + k * 1024); } while (0)
#define PG_MMA(ai, bj, At, Bt) do { __builtin_amdgcn_s_setprio(1); _Pragma("unroll") for (int m = 0; m < 4; ++m) _Pragma("unroll") for (int n = 0; n < 2; ++n) _Pragma("unroll") for (int k = 0; k < 2; ++k) \
        acc[ai][bj][m][n] = __builtin_amdgcn_mfma_f32_16x16x32_bf16(Bt[n][k], At[m][k], acc[ai][bj][m][n], 0, 0, 0); __builtin_amdgcn_s_setprio(0); } while (0)
#define PG_WAIT_V(n) asm volatile("s_waitcnt vmcnt(" #n ")" ::: "memory")
#define PG_WAIT_L(n) asm volatile("s_waitcnt lgkmcnt(" #n ")" ::: "memory")
#define PG_BAR __builtin_amdgcn_s_barrier()
#define PG_SCHED __builtin_amdgcn_sched_barrier(0)
#define PG_TILE(u, tau, A0, A1, B0, B1, S2) do { const int _t = (tau); \
        if (SEG2 && _t >= (u).nt) { const long _o = (long)(_t - (u).nt); A0 = (u).xa0 + _o * ks.a2; A1 = (u).xa1 + _o * ks.a2; B0 = (u).xb0 + _o * ks.b2; B1 = (u).xb1 + _o * ks.b2; S2 = true; } \
        else { const long _o = (long)_t; A0 = (u).a0 + _o * ks.a; A1 = (u).a1 + _o * ks.a; B0 = (u).b0 + _o * ks.b; B1 = (u).b1 + _o * ks.b; S2 = false; } } while (0)
    LAS int* idxl = (LAS int*)(lds + LDS_IDX_OFF + wid * 256);
#define PG_FETCH_IDX(u) do { const int _g = lane >> 4; const int _row = (_g >> 1) * 128 + ((wid >> 1) + 4 * (_g & 1)) * 16 + (lane & 15); \
        __builtin_amdgcn_global_load_lds((const unsigned*)((u).rows + _row), (LAS unsigned*)idxl, 4, 0, 0); } while (0)
#define PG_READ_IDX(u, V) do { _Pragma("unroll") for (int _h = 0; _h < 2; ++_h) _Pragma("unroll") for (int _i = 0; _i < 2; ++_i) { \
        const int _rp = _h * 128 + ((wid >> 1) + 4 * _i) * 16 + (lane >> 2); const int _e = idxl[(_h * 2 + _i) * 16 + (lane >> 2)]; \
        const int _tok = (_rp < (u).nrows) ? (_e >> 1) : 0; V[_h][_i] = _tok * gpitch + lo.a[_i]; } } while (0)
    GUnit cur, nxt; int ui = 0;
    if (!S.next(0, cur)) return;
    f32x4 acc[2][2][4][2];
#pragma unroll
    for (int a = 0; a < 2; ++a)
#pragma unroll
        for (int b = 0; b < 2; ++b)
#pragma unroll
            for (int m = 0; m < 4; ++m)
#pragma unroll
                for (int n = 0; n < 2; ++n) acc[a][b][m][n] = (f32x4){0.f, 0.f, 0.f, 0.f};
    bf16x8 At[4][2], B0[2][2], B1[2][2];
    int vA[2][2], vAn[2][2];
    if constexpr (GATHER) { PG_FETCH_IDX(cur); PG_WAIT_V(0); PG_READ_IDX(cur, vA); }
    else { vA[0][0] = vA[1][0] = lo.a[0]; vA[0][1] = vA[1][1] = lo.a[1]; }
#pragma unroll
    for (int h = 0; h < 2; ++h)
#pragma unroll
        for (int i = 0; i < 2; ++i) vAn[h][i] = vA[h][i];
    {
        const char *pa0, *pa1, *pb0, *pb1; bool s2;
        PG_TILE(cur, 0, pa0, pa1, pb0, pb1, s2);
        PG_STAGE(PG_SB(0, 0), pb0, lo.b[0], lo.b[1]); PG_STAGE(PG_SB(0, 1), pb1, lo.b[0], lo.b[1]); PG_STAGE(PG_SA(0, 0), pa0, vA[0][0], vA[0][1]); PG_STAGE(PG_SA(0, 1), pa1, vA[1][0], vA[1][1]);
        if (wr == 1) PG_BAR;
        PG_WAIT_V(2); PG_BAR;
        PG_TILE(cur, 1, pa0, pa1, pb0, pb1, s2);
        PG_STAGE(PG_SB(1, 0), pb0, lo.b[0], lo.b[1]); PG_STAGE(PG_SA(1, 0), pa0, vA[0][0], vA[0][1]); PG_STAGE(PG_SB(1, 1), pb1, lo.b[0], lo.b[1]);
        PG_WAIT_V(6); PG_BAR;
    }
    for (;;) {
        const bool has_next = S.next(ui + 1, nxt);
        const int ntt = cur.nt + (SEG2 ? cur.nt2 : 0);
#pragma clang loop unroll(disable)
        for (int t = 0; t < ntt; t += 2) {
            const bool last = (t == ntt - 2);
            if constexpr (GATHER) { if (has_next && t == ntt - 4) PG_FETCH_IDX(nxt); if (has_next && last) PG_READ_IDX(nxt, vAn); }
            const char *q0, *q1a1, *q2, *q3; bool s1; PG_TILE(cur, t + 1, q0, q1a1, q2, q3, s1); (void)q0; (void)q2; (void)q3;
            const char *a20, *a21, *b20, *b21, *a30, *a31, *b30, *b31; bool s2, s3;
            if (last) { if (has_next) { PG_TILE(nxt, 0, a20, a21, b20, b21, s2); PG_TILE(nxt, 1, a30, a31, b30, b31, s3); } else { PG_TILE(cur, 0, a20, a21, b20, b21, s2); PG_TILE(cur, 1, a30, a31, b30, b31, s3); } }
            else { PG_TILE(cur, t + 2, a20, a21, b20, b21, s2); PG_TILE(cur, t + 3, a30, a31, b30, b31, s3); }
            (void)a31;
            const bool nx2 = last && has_next;
            int o1a[2], o2a[2][2], o2b[2], o3a[2], o3b[2];
#pragma unroll
            for (int i = 0; i < 2; ++i) {
                o1a[i] = (SEG2 && s1) ? lo.a2[i] : vA[1][i];
                o2a[0][i] = (SEG2 && s2) ? lo.a2[i] : (nx2 ? vAn[0][i] : vA[0][i]); o2a[1][i] = (SEG2 && s2) ? lo.a2[i] : (nx2 ? vAn[1][i] : vA[1][i]);
                o2b[i] = (SEG2 && s2) ? lo.b2[i] : lo.b[i];
                o3a[i] = (SEG2 && s3) ? lo.a2[i] : (nx2 ? vAn[0][i] : vA[0][i]); o3b[i] = (SEG2 && s3) ? lo.b2[i] : lo.b[i];
            }
            PG_LDB(B0, 0, 0); PG_LDB(B1, 0, 1); PG_SCHED; PG_LDA(At, 0, 0); PG_STAGE(PG_SA(1, 1), q1a1, o1a[0], o1a[1]);
            PG_WAIT_V(8); PG_WAIT_L(0); PG_BAR; PG_MMA(0, 0, At, B0); PG_MMA(0, 1, At, B1); PG_BAR; PG_SCHED;
            PG_LDA(At, 0, 1); PG_STAGE(PG_SB(0, 0), b20, o2b[0], o2b[1]); PG_STAGE(PG_SB(0, 1), b21, o2b[0], o2b[1]); PG_STAGE(PG_SA(0, 0), a20, o2a[0][0], o2a[0][1]);
            PG_WAIT_V(8); PG_WAIT_L(0); PG_BAR; PG_MMA(1, 0, At, B0); PG_MMA(1, 1, At, B1); PG_BAR; PG_SCHED;
            PG_LDB(B0, 1, 0); PG_LDB(B1, 1, 1); PG_SCHED; PG_LDA(At, 1, 0); PG_STAGE(PG_SA(0, 1), a21, o2a[1][0], o2a[1][1]);
            PG_WAIT_V(8); PG_WAIT_L(0); PG_BAR; PG_MMA(0, 0, At, B0); PG_MMA(0, 1, At, B1); PG_BAR; PG_SCHED;
            PG_LDA(At, 1, 1); PG_STAGE(PG_SB(1, 0), b30, o3b[0], o3b[1]); PG_STAGE(PG_SB(1, 1), b31, o3b[0], o3b[1]); PG_STAGE(PG_SA(1, 0), a30, o3a[0], o3a[1]);
            PG_WAIT_V(8); PG_WAIT_L(0); PG_BAR; PG_MMA(1, 0, At, B0); PG_MMA(1, 1, At, B1); PG_BAR; PG_SCHED;
        }
        if constexpr (ALIGN_EPI) { if (wr == 0) PG_BAR; }
        if constexpr (!Epi::AFTER_DRAIN) { E(acc, cur, wr, wc, fr, fq); }
        if (!has_next) break;
#pragma unroll
        for (int a = 0; a < 2; ++a)
#pragma unroll
            for (int b = 0; b < 2; ++b)
#pragma unroll
                for (int m = 0; m < 4; ++m)
#pragma unroll
                    for (int n = 0; n < 2; ++n) acc[a][b][m][n] = (f32x4){0.f, 0.f, 0.f, 0.f};
        cur = nxt; ++ui;
#pragma unroll
        for (int h = 0; h < 2; ++h)
#pragma unroll
            for (int i = 0; i < 2; ++i) vA[h][i] = vAn[h][i];
        if constexpr (ALIGN_EPI) { if (wr == 1) PG_BAR; }
    }
    PG_WAIT_V(0);
    if constexpr (!ALIGN_EPI) { if (wr == 0) PG_BAR; }
    PG_BAR;
    if constexpr (Epi::AFTER_DRAIN) { E.fused(acc, cur, wr, wc, fr, fq, lds, wid, lane); }
#undef PG_SA
#undef PG_SB
#undef PG_STAGE
#undef PG_LDA
#undef PG_LDB
#undef PG_MMA
#undef PG_WAIT_V
#undef PG_WAIT_L
#undef PG_BAR
#undef PG_SCHED
#undef PG_TILE
#undef PG_FETCH_IDX
#undef PG_READ_IDX
}
__device__ __forceinline__ void lane_off_rowmajor(int (&v)[2], int pitch, bool perm) {
    int tid = threadIdx.x; asm volatile("" : "+v"(tid));
#pragma unroll
    for (int i = 0; i < 2; ++i) { int R, C; stage_rc(tid * 16 + i * 8192, R, C); const int Rb = perm ? ((R & ~31) + perm32(R & 31)) : R; v[i] = Rb * pitch + C * 2; }
}
}
__device__ __forceinline__ void p0_mods(Frame& F) {
    LAS float* sc = (LAS float*)F.lds;
    LAS float* red = (LAS float*)(F.lds + 32768);
    const float* c = F.in[I_C];
    for (int i = F.tid; i < NB * D; i += NTHR) { const float v = c[i]; sc[i] = v / (1.0f + __expf(-v)); }
    __syncthreads();
    float* mods = (float*)(F.ws + WS_MODS);
    const int seg = F.tid >> 6, col = F.tid & 63;
    for (int item = F.vcu; item < 224; item += F.G) {
        int set, c0, N; const float* W; const float* bias;
        if (item < 192) { set = item / 48; c0 = (item % 48) * 64; N = 3072; W = F.in[I_ADAW] + (size_t)set * D * 3072; bias = F.in[I_ADAB] + set * 3072; }
        else { set = 4; c0 = (item - 192) * 64; N = 2048; W = F.in[I_KVADAW]; bias = F.in[I_KVADAB]; }
        float acc[NB];
#pragma unroll
        for (int b = 0; b < NB; ++b) acc[b] = 0.f;
        const float* wp = W + (size_t)(seg * 128) * N + c0 + col;
#pragma unroll 8
        for (int d = 0; d < 128; ++d) { const float w = wp[(size_t)d * N];
#pragma unroll
            for (int b = 0; b < NB; ++b) acc[b] += sc[b * D + seg * 128 + d] * w; }
#pragma unroll
        for (int b = 0; b < NB; ++b) red[(seg * NB + b) * 64 + col] = acc[b];
        __syncthreads();
        { const int b = F.tid >> 6; float s = 0.f;
#pragma unroll
            for (int sg = 0; sg < 8; ++sg) s += red[(sg * NB + b) * 64 + col];
            mods[(set * NB + b) * 3072 + c0 + col] = s + bias[c0 + col]; }
        __syncthreads();
    }
}
template <class Map>
__device__ __forceinline__ void p0_tr_item(const float* W, int ldw, int K, bf16_t* WT, LAS float* scr, int item, int nblk, int lane, Map map) {
    const int kb = item / nblk, nb = item % nblk, k0 = 64 * kb, n0 = 32 * nb;
#pragma unroll 8
    for (int i = 0; i < 32; ++i) { const int kk = 2 * i + (lane >> 5); scr[kk * 33 + (lane & 31)] = W[(size_t)(k0 + kk) * ldw + n0 + (lane & 31)]; }
    LDS_WAIT(); asm volatile("" ::: "memory");
    const int c = lane & 7;
#pragma unroll
    for (int j = 0; j < 4; ++j) { const int n = (lane >> 3) + 8 * j; const LAS float* s = scr + (8 * c) * 33 + n;
        u32x4 o; o.x = pk2(s[0 * 33], s[1 * 33]); o.y = pk2(s[2 * 33], s[3 * 33]); o.z = pk2(s[4 * 33], s[5 * 33]); o.w = pk2(s[6 * 33], s[7 * 33]);
        *(u32x4*)(WT + (size_t)map(n0 + n) * K + k0 + 8 * c) = o; }
    LDS_WAIT(); asm volatile("" ::: "memory");
}
struct MapId { __device__ int operator()(int n) const { return n; } };
struct MapGlu { __device__ int operator()(int c) const { const int bj = c >> 10, cc = c & 1023; return (cc >> 7) * 256 + bj * 128 + (cc & 127); } };
struct MapHead { __device__ int operator()(int c) const { const int part = c >> 10, head = (c & 1023) >> 6, d = c & 63;
        const int pn = part * 4 + (head >> 2), wc = head & 3, fq = d >> 4, bj = (d >> 3) & 1, n = (d >> 2) & 1, j = d & 3; return pn * 256 + 128 * bj + 32 * wc + 16 * n + 4 * fq + j; } };
struct MapUp { int bj; __device__ int operator()(int f) const { return (f >> 7) * 256 + bj * 128 + (f & 127); } };
__device__ __forceinline__ void p0_convert(Frame& F) {
    LAS float* scr = (LAS float*)(F.lds + F.wave * 16384);
    const int gw = F.vcu * NWAVES + F.wave, NGW = F.G * NWAVES;
    constexpr int I_IN = 16 * 32, I_OUT = 16 * 64, I_KV = 16 * 64, I_QG = 16 * 64, I_O = 16 * 32, I_UP = 16 * 8, I_DN = 4 * 32;
    constexpr int NITEMS = I_IN + I_OUT + I_KV + I_QG + I_O + 64 * (2 * I_UP + I_DN);
    unsigned char* ws = F.ws;
    for (int it = gw; it < NITEMS; it += NGW) {
        int r = it;
        if (r < I_IN) { p0_tr_item(F.in[I_WIN], 1024, 1024, (bf16_t*)(ws + WS_BT_IN), scr, r, 32, F.lane, MapId()); continue; } r -= I_IN;
        if (r < I_OUT) { p0_tr_item(F.in[I_WOUT], 2048, 1024, (bf16_t*)(ws + WS_BT_OUT), scr, r, 64, F.lane, MapGlu()); continue; } r -= I_OUT;
        if (r < I_KV) { p0_tr_item(F.in[I_KVW], 2064, 1024, (bf16_t*)(ws + WS_BT_KV), scr, r, 64, F.lane, MapHead()); continue; } r -= I_KV;
        if (r < I_QG) { p0_tr_item(F.in[I_WQG], 2048, 1024, (bf16_t*)(ws + WS_BT_QG), scr, r, 64, F.lane, MapHead()); continue; } r -= I_QG;
        if (r < I_O) { p0_tr_item(F.in[I_WO], 1024, 1024, (bf16_t*)(ws + WS_BT_O), scr, r, 32, F.lane, MapId()); continue; } r -= I_O;
        const int le = r / (2 * I_UP + I_DN), q = r % (2 * I_UP + I_DN);
        if (q < I_UP) { MapUp m{0}; p0_tr_item(F.in[I_MW1] + (size_t)le * D * FH, 256, 1024, (bf16_t*)(ws + WS_BT1) + (size_t)le * 512 * 1024, scr, q, 8, F.lane, m); }
        else if (q < 2 * I_UP) { MapUp m{1}; p0_tr_item(F.in[I_MW3] + (size_t)le * D * FH, 256, 1024, (bf16_t*)(ws + WS_BT1) + (size_t)le * 512 * 1024, scr, q - I_UP, 8, F.lane, m); }
        else p0_tr_item(F.in[I_MW2] + (size_t)le * FH * D, 1024, 256, (bf16_t*)(ws + WS_BT2) + (size_t)le * 1024 * 256, scr, q - 2 * I_UP, 32, F.lane, MapId());
    }
    const int gt = F.vcu * NTHR + F.tid, NGT = F.G * NTHR;
    for (int it = gt; it < 3 * 256 * 128; it += NGT) {
        const int m = it / (256 * 128), row = (it / 128) % 256, k0 = (it % 128) * 8;
        float v[8];
#pragma unroll
        for (int j = 0; j < 8; ++j) v[j] = 0.f;
        bf16_t* dst;
        if (m == 0) { dst = (bf16_t*)(ws + WS_BT_FZ);
            if (row < 16) {
#pragma unroll
                for (int j = 0; j < 8; ++j) v[j] = F.in[I_KVW][(size_t)(k0 + j) * 2064 + 2048 + row]; } }
        else { const int l = m - 1; dst = (bf16_t*)(ws + WS_BT_R) + (size_t)l * 256 * 1024;
            if (row < 32) { const int grp = (row & 15) >> 2, e = grp * 8 + (row >> 4) * 4 + (row & 3);
#pragma unroll
                for (int j = 0; j < 8; ++j) v[j] = F.in[I_MWE][(size_t)l * D * 32 + (size_t)(k0 + j) * 32 + e]; }
            else if (row >= 128 && row < 144 && (row & 3) == 0) { const int grp = (row - 128) >> 2;
#pragma unroll
                for (int j = 0; j < 8; ++j) v[j] = F.in[I_MWG][(size_t)l * D * 4 + (size_t)(k0 + j) * 4 + grp]; } }
        u32x4 o; o.x = pk2(v[0], v[1]); o.y = pk2(v[2], v[3]); o.z = pk2(v[4], v[5]); o.w = pk2(v[6], v[7]);
        *(u32x4*)(dst + (size_t)row * 1024 + k0) = o;
    }
}
__device__ __forceinline__ void p0_s5_tables(Frame& F) {
    LAS double* lam = (LAS double*)F.lds;
    LAS f32x2* bb = (LAS f32x2*)(F.lds + 1024);
    LAS f32x2* Cc = (LAS f32x2*)(F.lds + 1024 + 8192);
    LAS f32x2* pw = (LAS f32x2*)(F.lds + 1024 + 16384);
    unsigned char* ws = F.ws;
    for (int job = F.vcu; job < 256; job += F.G) {
        const int g = job >> 2, q = job & 3;
        __syncthreads();
        if (F.tid < 64) { const int p = F.tid;
            const double dt = exp((double)F.in[I_LOGDT][g]), lr = F.in[I_LRE][g * P + p], li = F.in[I_LIM][g * P + p];
            const double mag = exp(lr * dt), ar = mag * cos(li * dt), ai = mag * sin(li * dt), den = lr * lr + li * li;
            const double cr = ((ar - 1.0) * lr + ai * li) / den, ci = (ai * lr - (ar - 1.0) * li) / den;
            lam[2 * p] = lr * dt; lam[2 * p + 1] = li * dt;
            for (int c = 0; c < GC; ++c) { const double br = F.in[I_BRE][(g * P + p) * GC + c], bi = F.in[I_BIM][(g * P + p) * GC + c];
                bb[p * GC + c] = (f32x2){(float)(cr * br - ci * bi), (float)(cr * bi + ci * br)}; } }
        for (int i = F.tid; i < GC * P; i += NTHR) Cc[i] = (f32x2){F.in[I_CRE][g * GC * P + i], F.in[I_CIM][g * GC * P + i]};
        __syncthreads();
        for (int i = F.tid; i < 65 * 64; i += NTHR) { const int lag = i >> 6, p = i & 63; const double m = exp(lam[2 * p] * lag), ph = lam[2 * p + 1] * lag; pw[i] = (f32x2){(float)(m * cos(ph)), (float)(m * sin(ph))}; }
        __syncthreads();
        if (q == 0 && F.tid < 64) ((f32x2*)(ws + WS_A64))[g * P + F.tid] = pw[64 * 64 + F.tid];
        bf16_t* kt = (bf16_t*)(ws + WS_KTAB) + (size_t)g * KTAB_G;
        for (int i = F.tid; i < 16 * 256; i += NTHR) { const int lag = 16 * q + (i >> 8), c = (i >> 4) & 15, c2 = i & 15; float s = 0.f;
            for (int p = 0; p < P; ++p) { const f32x2 cv = Cc[c * P + p], a = pw[lag * 64 + p], b = bb[p * GC + c2];
                const float tr = cv.x * a.x - cv.y * a.y, ti = cv.x * a.y + cv.y * a.x; s += tr * b.x - ti * b.y; }
            kt[(lag + 63) * 256 + c * 16 + c2] = (bf16_t)f2bf(s);
            if (lag < 63) kt[lag * 256 + c * 16 + c2] = 0; }
        bf16_t* wb = (bf16_t*)(ws + WS_WB) + (size_t)g * 128 * 1024;
        for (int i = F.tid; i < 64 * 256; i += NTHR) { const int p = i >> 8, jl = (i >> 4) & 15, c2 = i & 15, j = 16 * q + jl; const f32x2 a = pw[(63 - j) * 64 + p], b = bb[p * GC + c2];
            wb[(size_t)p * 1024 + j * 16 + c2] = (bf16_t)f2bf(a.x * b.x - a.y * b.y); wb[(size_t)(64 + p) * 1024 + j * 16 + c2] = (bf16_t)f2bf(a.x * b.y + a.y * b.x); }
        bf16_t* vt = (bf16_t*)(ws + WS_VT) + (size_t)g * 1024 * 128;
        for (int i = F.tid; i < 256 * 64; i += NTHR) { const int tc = i >> 6, p = i & 63, t = 16 * q + (tc >> 4), c = tc & 15; const f32x2 cv = Cc[c * P + p], a = pw[(t + 1) * 64 + p];
            vt[(size_t)(t * 16 + c) * 128 + p] = (bf16_t)f2bf(cv.x * a.x - cv.y * a.y); vt[(size_t)(t * 16 + c) * 128 + 64 + p] = (bf16_t)f2bf(-(cv.x * a.y + cv.y * a.x)); }
    }
    __syncthreads();
}

template <bool SRC_F32>
__device__ __forceinline__ void rows_norm_mod(Frame& F, const void* src, const float* g, const float* mod  , bf16_t* dst) {
    const int rows_per_blk = T / F.G;
    for (int r0 = F.vcu * rows_per_blk; r0 < T; r0 += F.G * rows_per_blk) {
        const int b = r0 / L;
        float gs[16], sh[16];
#pragma unroll
        for (int hlf = 0; hlf < 2; ++hlf)
#pragma unroll
            for (int j = 0; j < 8; ++j) { const int d = hlf * 512 + F.lane * 8 + j; gs[hlf * 8 + j] = g[d] * (1.0f + mod[b * 3072 + 1024 + d]); sh[hlf * 8 + j] = mod[b * 3072 + d]; }
        for (int row = r0 + F.wave; row < r0 + rows_per_blk; row += NWAVES) {
            float v[16];
            if constexpr (SRC_F32) { const float* s = (const float*)src + (size_t)row * D;
#pragma unroll
                for (int hlf = 0; hlf < 2; ++hlf) { const f32x4 x0 = *(const f32x4*)(s + hlf * 512 + F.lane * 8), x1 = *(const f32x4*)(s + hlf * 512 + F.lane * 8 + 4);
                    v[hlf * 8 + 0] = x0.x; v[hlf * 8 + 1] = x0.y; v[hlf * 8 + 2] = x0.z; v[hlf * 8 + 3] = x0.w; v[hlf * 8 + 4] = x1.x; v[hlf * 8 + 5] = x1.y; v[hlf * 8 + 6] = x1.z; v[hlf * 8 + 7] = x1.w; } }
            else { const bf16_t* s = (const bf16_t*)src + (size_t)row * D;
#pragma unroll
                for (int hlf = 0; hlf < 2; ++hlf) { const u32x4 x = *(const u32x4*)(s + hlf * 512 + F.lane * 8);
                    v[hlf * 8 + 0] = bflo(x.x); v[hlf * 8 + 1] = bfhi(x.x); v[hlf * 8 + 2] = bflo(x.y); v[hlf * 8 + 3] = bfhi(x.y); v[hlf * 8 + 4] = bflo(x.z); v[hlf * 8 + 5] = bfhi(x.z); v[hlf * 8 + 6] = bflo(x.w); v[hlf * 8 + 7] = bfhi(x.w); } }
            float ss = 0.f;
#pragma unroll
            for (int j = 0; j < 16; ++j) ss += v[j] * v[j];
            const float rstd = 1.0f / sqrtf(wave_sum(ss) * (1.0f / D) + EPS);
#pragma unroll
            for (int hlf = 0; hlf < 2; ++hlf) { u32x4 o; float y[8];
#pragma unroll
                for (int j = 0; j < 8; ++j) y[j] = v[hlf * 8 + j] * rstd * gs[hlf * 8 + j] + sh[hlf * 8 + j];
                o.x = pk2(y[0], y[1]); o.y = pk2(y[2], y[3]); o.z = pk2(y[4], y[5]); o.w = pk2(y[6], y[7]);
                *(u32x4*)(dst + (size_t)row * D + hlf * 512 + F.lane * 8) = o; }
        }
    }
}
struct SchedDense {
    pg::DenseOrder o; const char* A; const char* B; int apitch, bpitch, nt;
    __device__ bool next(int i, pg::GUnit& u) const { int pm, pn; if (!o.next(i, pm, pn)) return false;
        u.a0 = A + (size_t)pm * 256 * apitch; u.a1 = u.a0 + (size_t)128 * apitch; u.b0 = B + (size_t)pn * 256 * bpitch; u.b1 = u.b0 + (size_t)128 * bpitch; u.nt = nt; u.nt2 = 0; u.i0 = pm; u.i1 = pn; return true; }
};
struct EpiToGM { static constexpr bool PERM = true, AFTER_DRAIN = false; bf16_t* dst;
    __device__ __forceinline__ void operator()(const f32x4 (&acc)[2][2][4][2], const pg::GUnit& u, int wr, int wc, int fr, int fq) const {
        const int row0 = u.i0 * 256 + wr * 64 + fr, col0 = u.i1 * 256 + wc * 32 + 8 * fq;
#pragma unroll
        for (int ai = 0; ai < 2; ++ai)
#pragma unroll
            for (int m = 0; m < 4; ++m) { const int row = row0 + ai * 128 + m * 16;
#pragma unroll
                for (int bj = 0; bj < 2; ++bj) { const int c = col0 + bj * 128; const f32x4 v0 = acc[ai][bj][m][0], v1 = acc[ai][bj][m][1];
                    u32x4 w; w.x = pk2(v0[0], v0[1]); w.y = pk2(v0[2], v0[3]); w.z = pk2(v1[0], v1[1]); w.w = pk2(v1[2], v1[3]);
                    *(u32x4*)(dst + ((size_t)(c >> 4) * T + row) * 16 + (c & 15)) = w; } }
    }
};
struct SchedE { int c, Gd; const char* U; const char* Wb;
    __device__ bool next(int i, pg::GUnit& u) const { const int Li = i * Gd + c; if (i > 0 || Li >= 128) return false; const int g = Li >> 1, pm = Li & 1;
        u.a0 = U + (size_t)g * T * 32 + (size_t)pm * 256 * 2048; u.a1 = u.a0 + 128 * 2048; u.b0 = Wb + (size_t)g * 128 * 2048; u.b1 = u.b0; u.nt = 16; u.nt2 = 0; u.i0 = g; u.i1 = pm; return true; }
};
struct EpiScan { static constexpr bool PERM = false, AFTER_DRAIN = true; bf16_t* Sb; const f32x2* a64;
    __device__ __forceinline__ void fused(const f32x4 (&acc)[2][2][4][2], const pg::GUnit& u, int wr, int wc, int fr, int fq, LAS unsigned char* lds, int wid, int lane) const {
        LAS float* e = (LAS float*)lds;
#pragma unroll
        for (int ai = 0; ai < 2; ++ai)
#pragma unroll
            for (int m = 0; m < 4; ++m) { const int row = ai * 128 + wr * 64 + m * 16 + fr;
#pragma unroll
                for (int n = 0; n < 2; ++n) *(LAS f32x4*)(e + row * 128 + wc * 32 + n * 16 + 4 * fq) = acc[ai][0][m][n]; }
        LDS_WAIT(); __builtin_amdgcn_s_barrier(); asm volatile("" ::: "memory");
        const int tid = wid * 64 + lane;
        if (tid < 256) { const int bl = tid >> 6, p = tid & 63, g = u.i0; const f32x2 a = a64[g * P + p];
            bf16_t* out = Sb + ((size_t)g * 512 + (size_t)(u.i1 * 4 + bl) * 64) * 128;
            float sr = 0.f, si = 0.f;
            for (int k = 0; k < 64; ++k) { out[k * 128 + p] = (bf16_t)f2bf(sr); out[k * 128 + 64 + p] = (bf16_t)f2bf(si);
                const float er = e[(bl * 64 + k) * 128 + p], ei = e[(bl * 64 + k) * 128 + 64 + p];
                const float nr = a.x * sr - a.y * si + er, ni = a.x * si + a.y * sr + ei; sr = nr; si = ni; } }
    }
};
struct SchedY { int c, Gd; const char* U; const char* Sb; const char* Kt; const char* Vt;
    __device__ bool next(int i, pg::GUnit& u) const { const int Li = i * Gd + c; if (Li >= 512) return false; const int r = Li & 255, g = r >> 2, pm = (r >> 1) & 1, s = r & 1, pn = (Li < 256) ? s : 3 - s;
        u.a0 = U + (size_t)g * T * 32 + (size_t)pm * 256 * 2048; u.a1 = u.a0 + 128 * 2048;
        u.b0 = Kt + ((size_t)g * KTAB_G + (size_t)(16 * pn + 63) * 256) * 2; u.b1 = u.b0 + 8 * 512; u.nt = 4 * pn + 4;
        u.xa0 = Sb + ((size_t)g * 512 + pm * 256) * 256; u.xa1 = u.xa0 + 128 * 256; u.xb0 = Vt + ((size_t)g * 1024 + pn * 256) * 256; u.xb1 = u.xb0 + 128 * 256; u.nt2 = 2;
        u.i0 = g; u.i1 = pm; u.i2 = pn; return true; }
};
struct EpiY { static constexpr bool PERM = true, AFTER_DRAIN = false; const bf16_t* U; bf16_t* Y; const float* dsk;
    __device__ __forceinline__ void operator()(const f32x4 (&acc)[2][2][4][2], const pg::GUnit& u, int wr, int wc, int fr, int fq) const {
        const int g = u.i0, bk0 = u.i1 * 256 + wr * 64 + fr, c0 = wc * 32 + 8 * fq;
        const int cc = c0 & 15; float dk[8];
#pragma unroll
        for (int j = 0; j < 8; ++j) dk[j] = dsk[g * 16 + cc + j];
#pragma unroll
        for (int ai = 0; ai < 2; ++ai)
#pragma unroll
            for (int m = 0; m < 4; ++m) { const int bk = bk0 + ai * 128 + m * 16;
#pragma unroll
                for (int bj = 0; bj < 2; ++bj) { const int t = 16 * u.i2 + ((c0 + 128 * bj) >> 4); const size_t off = ((size_t)g * T + (size_t)bk * 64 + t) * 16 + cc;
                    const u32x4 uu = *(const u32x4*)(U + off); const f32x4 v0 = acc[ai][bj][m][0], v1 = acc[ai][bj][m][1];
                    float y[8] = {v0[0] + dk[0] * bflo(uu.x), v0[1] + dk[1] * bfhi(uu.x), v0[2] + dk[2] * bflo(uu.y), v0[3] + dk[3] * bfhi(uu.y),
                                  v1[0] + dk[4] * bflo(uu.z), v1[1] + dk[5] * bfhi(uu.z), v1[2] + dk[6] * bflo(uu.w), v1[3] + dk[7] * bfhi(uu.w)};
#pragma unroll
                    for (int j = 0; j < 8; ++j) y[j] = fast_gelu_tanh(y[j]);
                    u32x4 w; w.x = pk2(y[0], y[1]); w.y = pk2(y[2], y[3]); w.z = pk2(y[4], y[5]); w.w = pk2(y[6], y[7]);
                    *(u32x4*)(Y + off) = w; } }
    }
};
struct SchedOut { pg::DenseOrder o; const char* Y; const char* B;
    __device__ bool next(int i, pg::GUnit& u) const { int pm, pn; if (!o.next(i, pm, pn)) return false;
        u.a0 = Y + (size_t)pm * 256 * 32; u.a1 = u.a0 + 128 * 32; u.b0 = B + (size_t)pn * 256 * 2048; u.b1 = u.b0 + 128 * 2048; u.nt = 16; u.nt2 = 0; u.i0 = pm; u.i1 = pn; return true; }
};
struct EpiGluRes { static constexpr bool PERM = true, AFTER_DRAIN = false; const float* x; const float* mod  ; bf16_t* h1;
    __device__ __forceinline__ void operator()(const f32x4 (&acc)[2][2][4][2], const pg::GUnit& u, int wr, int wc, int fr, int fq) const {
        const int row0 = u.i0 * 256 + wr * 64 + fr, col = u.i1 * 128 + wc * 32 + 8 * fq, b = (u.i0 * 256) / L;
        float gt[8];
#pragma unroll
        for (int j = 0; j < 8; ++j) gt[j] = mod[b * 3072 + 2048 + col + j];
#pragma unroll
        for (int ai = 0; ai < 2; ++ai)
#pragma unroll
            for (int m = 0; m < 4; ++m) { const size_t off = (size_t)(row0 + ai * 128 + m * 16) * D + col;
                const f32x4 x0 = *(const f32x4*)(x + off), x1 = *(const f32x4*)(x + off + 4);
                const f32x4 a0 = acc[ai][0][m][0], a1 = acc[ai][0][m][1], g0 = acc[ai][1][m][0], g1 = acc[ai][1][m][1];
                float y[8];
#pragma unroll
                for (int j = 0; j < 4; ++j) { y[j] = x0[j] + gt[j] * a0[j] * fast_sigmoid(g0[j]); y[4 + j] = x1[j] + gt[4 + j] * a1[j] * fast_sigmoid(g1[j]); }
                u32x4 w; w.x = pk2(y[0], y[1]); w.y = pk2(y[2], y[3]); w.z = pk2(y[4], y[5]); w.w = pk2(y[6], y[7]);
                *(u32x4*)(h1 + off) = w; }
    }
};
constexpr int LIST_CAP = 32768;
struct EpiRoute { static constexpr bool PERM = false, AFTER_DRAIN = false; const float* bg; const float* be; unsigned* cnt; int* list; float* ew;
    __device__ __forceinline__ void operator()(const f32x4 (&acc)[2][2][4][2], const pg::GUnit& u, int wr, int wc, int fr, int fq) const {
        if (wc != 0) return;
        float bev[8];
#pragma unroll
        for (int j = 0; j < 8; ++j) bev[j] = be[fq * 8 + j];
        const float bgv = bg[fq];
#pragma unroll
        for (int ai = 0; ai < 2; ++ai)
#pragma unroll
            for (int m = 0; m < 4; ++m) {
                const int row = u.i0 * 256 + ai * 128 + wr * 64 + m * 16 + fr;
                float el[8];
#pragma unroll
                for (int j = 0; j < 4; ++j) { el[j] = acc[ai][0][m][0][j] + bev[j]; el[4 + j] = acc[ai][0][m][1][j] + bev[4 + j]; }
                const float gl = acc[ai][1][m][0][0] + bgv;
                float gk[4];
#pragma unroll
                for (int k = 0; k < 4; ++k) gk[k] = __shfl(gl, k * 16 + fr);
                int gi = 0; float gm = gk[0];
#pragma unroll
                for (int k = 1; k < 4; ++k) if (gk[k] > gm) { gm = gk[k]; gi = k; }
                float se = 0.f;
#pragma unroll
                for (int k = 0; k < 4; ++k) se += __expf(gk[k] - gm);
                const float pgv = 1.0f / se;
                if (fq == gi) {
                    float v1 = -3.0e38f, v2 = -3.0e38f; int i1 = 0, i2 = 0;
#pragma unroll
                    for (int j = 0; j < 8; ++j) { const float v = el[j]; if (v > v1) { v2 = v1; i2 = i1; v1 = v; i1 = j; } else if (v > v2) { v2 = v; i2 = j; } }
                    const float e2 = __expf(v2 - v1), w1 = pgv / (1.0f + e2), w2 = pgv * e2 / (1.0f + e2);
                    const int ea = gi * 8 + i1, eb = gi * 8 + i2;
                    const unsigned pa = atomicAdd(cnt + ea, 1u), pb = atomicAdd(cnt + eb, 1u);
                    list[ea * LIST_CAP + pa] = row * 2; list[eb * LIST_CAP + pb] = row * 2 + 1;
                    ew[row * 2] = w1; ew[row * 2 + 1] = w2;
                }
            }
    }
};
__device__ __forceinline__ void moe_tile_table(Frame& F, const unsigned* cnt) {
    LAS int* tb = (LAS int*)(F.lds + LDSCTL_OFF); LAS int* cn = tb + 33;
    if (F.tid == 0) { int s = 0; for (int e = 0; e < NE; ++e) { const int c = (int)__hip_atomic_load(cnt + e, __ATOMIC_RELAXED, __HIP_MEMORY_SCOPE_AGENT); tb[e] = s; cn[e] = c; s += (c + 255) >> 8; } tb[NE] = s; }
    __syncthreads();
}
__device__ __forceinline__ bool moe_find(LAS const int* tb, int mt, int& e, int& ti, int& nrows) {
    const int tot = __builtin_amdgcn_readfirstlane(tb[NE]); if (mt >= tot) return false;
    int ee = 0;
#pragma unroll 1
    for (int k = 1; k < NE; ++k) if (tb[k] <= mt) ee = k;
    ee = __builtin_amdgcn_readfirstlane(ee);
    const int t0 = __builtin_amdgcn_readfirstlane(tb[ee]), c = __builtin_amdgcn_readfirstlane(tb[33 + ee]);
    e = ee; ti = mt - t0; const int rem = c - ti * 256; nrows = rem < 256 ? rem : 256; return true;
}
struct SchedMoe1 { int c, Gd; LAS const int* tb; const char* hn; const char* Bt; const int* list;
    __device__ bool next(int i, pg::GUnit& u) const { const int Li = i * Gd + c, mt = Li >> 1, pn = Li & 1; int e, ti, nr; if (!moe_find(tb, mt, e, ti, nr)) return false;
        u.a0 = hn; u.a1 = hn; u.b0 = Bt + ((size_t)e * 512 + pn * 256) * 2048; u.b1 = u.b0 + 128 * 2048; u.nt = 16; u.nt2 = 0;
        u.rows = list + (size_t)e * LIST_CAP + ti * 256; u.nrows = nr; u.i0 = mt; u.i1 = pn; return true; }
};
struct EpiMoe1 { static constexpr bool PERM = true, AFTER_DRAIN = false; bf16_t* hmid;
    __device__ __forceinline__ void operator()(const f32x4 (&acc)[2][2][4][2], const pg::GUnit& u, int wr, int wc, int fr, int fq) const {
        const int row0 = u.i0 * 256 + wr * 64 + fr, col = u.i1 * 128 + wc * 32 + 8 * fq;
#pragma unroll
        for (int ai = 0; ai < 2; ++ai)
#pragma unroll
            for (int m = 0; m < 4; ++m) { const f32x4 a0 = acc[ai][0][m][0], a1 = acc[ai][0][m][1], b0 = acc[ai][1][m][0], b1 = acc[ai][1][m][1]; float y[8];
#pragma unroll
                for (int j = 0; j < 4; ++j) { y[j] = fast_silu(a0[j]) * b0[j]; y[4 + j] = fast_silu(a1[j]) * b1[j]; }
                u32x4 w; w.x = pk2(y[0], y[1]); w.y = pk2(y[2], y[3]); w.z = pk2(y[4], y[5]); w.w = pk2(y[6], y[7]);
                *(u32x4*)(hmid + (size_t)(row0 + ai * 128 + m * 16) * 256 + col) = w; }
    }
};
struct SchedMoe2 { int c, Gd; LAS const int* tb; const char* hmid; const char* Bt; const int* list;
    __device__ bool next(int i, pg::GUnit& u) const { const int Li = i * Gd + c, mt = Li >> 2, pn = Li & 3; int e, ti, nr; if (!moe_find(tb, mt, e, ti, nr)) return false;
        u.a0 = hmid + (size_t)mt * 256 * 512; u.a1 = u.a0 + 128 * 512; u.b0 = Bt + ((size_t)e * 1024 + pn * 256) * 512; u.b1 = u.b0 + 128 * 512; u.nt = 4; u.nt2 = 0;
        u.rows = list + (size_t)e * LIST_CAP + ti * 256; u.nrows = nr; u.i0 = mt; u.i1 = pn; return true; }
};
struct EpiMoe2 { static constexpr bool PERM = true, AFTER_DRAIN = false; bf16_t* y0  ; const float* ew;
    __device__ __forceinline__ void operator()(const f32x4 (&acc)[2][2][4][2], const pg::GUnit& u, int wr, int wc, int fr, int fq) const {
        const int r0 = wr * 64 + fr, col = u.i1 * 256 + wc * 32 + 8 * fq;
#pragma unroll
        for (int ai = 0; ai < 2; ++ai)
#pragma unroll
            for (int m = 0; m < 4; ++m) { const int r = r0 + ai * 128 + m * 16; const bool ok = r < u.nrows;
                const int ent = ok ? u.rows[r] : 0; const float w = ew[ent];
                const unsigned off = ((unsigned)(ent & 1) * (unsigned)T + (unsigned)(ent >> 1)) * (unsigned)D + (unsigned)col;
                if (ok) {
#pragma unroll
                    for (int bj = 0; bj < 2; ++bj) { const f32x4 v0 = acc[ai][bj][m][0], v1 = acc[ai][bj][m][1];
                        u32x4 o; o.x = pk2(v0[0] * w, v0[1] * w); o.y = pk2(v0[2] * w, v0[3] * w); o.z = pk2(v1[0] * w, v1[1] * w); o.w = pk2(v1[2] * w, v1[3] * w);
                        *(u32x4*)(y0 + off + bj * 128) = o; } }
                asm volatile("" ::: "memory"); }
    }
};
template <bool OUT_F32, int NNORM>
__device__ __forceinline__ void rows_combine(Frame& F, const bf16_t* h, const bf16_t* y0, const bf16_t* y1, const float* gmod  , bf16_t* hb, float* hf,
                                              const float* gA, const float* modA, bf16_t* dA, const float* gB, const float* modB, bf16_t* dB) {
    const int rows_per_blk = T / F.G;
    for (int r0 = F.vcu * rows_per_blk; r0 < T; r0 += F.G * rows_per_blk) {
        const int b = r0 / L;
        for (int row = r0 + F.wave; row < r0 + rows_per_blk; row += NWAVES) {
            float v[16];
#pragma unroll
            for (int hlf = 0; hlf < 2; ++hlf) { const size_t off = (size_t)row * D + hlf * 512 + F.lane * 8; const int d0 = hlf * 512 + F.lane * 8;
                const u32x4 xh = *(const u32x4*)(h + off), a = *(const u32x4*)(y0 + off), c = *(const u32x4*)(y1 + off);
                const f32x4 g0 = *(const f32x4*)(gmod + b * 3072 + 2048 + d0), g1 = *(const f32x4*)(gmod + b * 3072 + 2048 + d0 + 4);
                v[hlf * 8 + 0] = bflo(xh.x) + g0.x * (bflo(a.x) + bflo(c.x)); v[hlf * 8 + 1] = bfhi(xh.x) + g0.y * (bfhi(a.x) + bfhi(c.x));
                v[hlf * 8 + 2] = bflo(xh.y) + g0.z * (bflo(a.y) + bflo(c.y)); v[hlf * 8 + 3] = bfhi(xh.y) + g0.w * (bfhi(a.y) + bfhi(c.y));
                v[hlf * 8 + 4] = bflo(xh.z) + g1.x * (bflo(a.z) + bflo(c.z)); v[hlf * 8 + 5] = bfhi(xh.z) + g1.y * (bfhi(a.z) + bfhi(c.z));
                v[hlf * 8 + 6] = bflo(xh.w) + g1.z * (bflo(a.w) + bflo(c.w)); v[hlf * 8 + 7] = bfhi(xh.w) + g1.w * (bfhi(a.w) + bfhi(c.w));
                if constexpr (OUT_F32) { *(f32x4*)(hf + off) = (f32x4){v[hlf * 8 + 0], v[hlf * 8 + 1], v[hlf * 8 + 2], v[hlf * 8 + 3]}; *(f32x4*)(hf + off + 4) = (f32x4){v[hlf * 8 + 4], v[hlf * 8 + 5], v[hlf * 8 + 6], v[hlf * 8 + 7]}; }
                else { u32x4 o; o.x = pk2(v[hlf * 8 + 0], v[hlf * 8 + 1]); o.y = pk2(v[hlf * 8 + 2], v[hlf * 8 + 3]); o.z = pk2(v[hlf * 8 + 4], v[hlf * 8 + 5]); o.w = pk2(v[hlf * 8 + 6], v[hlf * 8 + 7]); *(u32x4*)(hb + off) = o; } }
            if constexpr (NNORM > 0) {
                float ss = 0.f;
#pragma unroll
                for (int j = 0; j < 16; ++j) ss += v[j] * v[j];
                const float rstd = 1.0f / sqrtf(wave_sum(ss) * (1.0f / D) + EPS);
#pragma unroll
                for (int which = 0; which < NNORM; ++which) { const float* g = which ? gB : gA; const float* mod = which ? modB : modA; bf16_t* dst = which ? dB : dA;
#pragma unroll
                    for (int hlf = 0; hlf < 2; ++hlf) { const int d0 = hlf * 512 + F.lane * 8; float y[8];
#pragma unroll
                        for (int j = 0; j < 8; ++j) y[j] = v[hlf * 8 + j] * rstd * g[d0 + j] * (1.0f + mod[b * 3072 + 1024 + d0 + j]) + mod[b * 3072 + d0 + j];
                        u32x4 o; o.x = pk2(y[0], y[1]); o.y = pk2(y[2], y[3]); o.z = pk2(y[4], y[5]); o.w = pk2(y[6], y[7]);
                        *(u32x4*)(dst + (size_t)row * D + d0) = o; } }
            }
        }
    }
}

__device__ __forceinline__ void ph_route(Frame& F, int l, const bf16_t* hn) {
    unsigned char* ws = F.ws; unsigned* ctl = (unsigned*)(ws + WS_CTL);
    SchedDense S; S.o.init(T, 256, F.G, (int)blockIdx.x); S.A = (const char*)hn; S.B = (const char*)(ws + WS_BT_R) + (size_t)l * 256 * 2048; S.apitch = 2048; S.bpitch = 2048; S.nt = 16;
    EpiRoute E{F.in[I_MBG] + l * 4, F.in[I_MBE] + l * 32, ctl + CW_CNT + l * 32, (int*)(ws + WS_LIST), (float*)(ws + WS_EW)};
    pg::KStep ks{128, 128, 0, 0}; pg::LaneOff lo_{}; pg::lane_off_rowmajor(lo_.a, 2048, false); pg::lane_off_rowmajor(lo_.b, 2048, false);
    pg::gemm_phase<EpiRoute, SchedDense, false, false, false>(F.lds, S, E, ks, lo_, 0);
}
__device__ __forceinline__ void ph_moe_up(Frame& F, int l, const bf16_t* hn, bf16_t* hmid) {
    unsigned char* ws = F.ws; unsigned* ctl = (unsigned*)(ws + WS_CTL);
    moe_tile_table(F, ctl + CW_CNT + l * 32);
    SchedMoe1 S{F.vcu, F.G, (LAS const int*)(F.lds + LDSCTL_OFF), (const char*)hn, (const char*)(ws + WS_BT1) + (size_t)l * 32 * 512 * 2048, (const int*)(ws + WS_LIST)};
    EpiMoe1 E{hmid}; pg::KStep ks{128, 128, 0, 0}; pg::LaneOff lo_{}; pg::lane_off_rowmajor(lo_.a, 0, false); pg::lane_off_rowmajor(lo_.b, 2048, true);
    pg::gemm_phase<EpiMoe1, SchedMoe1, false, true, true>(F.lds, S, E, ks, lo_, 2048);
}
__device__ __forceinline__ void ph_moe_down(Frame& F, int l, const bf16_t* hmid, bf16_t* y0, bf16_t* y1) {
    unsigned char* ws = F.ws; unsigned* ctl = (unsigned*)(ws + WS_CTL);
    moe_tile_table(F, ctl + CW_CNT + l * 32);
    SchedMoe2 S{F.vcu, F.G, (LAS const int*)(F.lds + LDSCTL_OFF), (const char*)hmid, (const char*)(ws + WS_BT2) + (size_t)l * 32 * 1024 * 512, (const int*)(ws + WS_LIST)};
    EpiMoe2 E{y0, (const float*)(ws + WS_EW)}; (void)y1; pg::KStep ks{128, 128, 0, 0}; pg::LaneOff lo_{}; pg::lane_off_rowmajor(lo_.a, 512, false); pg::lane_off_rowmajor(lo_.b, 512, true);
    pg::gemm_phase<EpiMoe2, SchedMoe2, false, false, true>(F.lds, S, E, ks, lo_, 0);
}
struct SchedHeads { pg::DenseOrder o; const char* A; const char* B; const char* Bx  ;
    __device__ bool next(int i, pg::GUnit& u) const { int pm, pn; if (!o.next(i, pm, pn)) return false;
        u.a0 = A + (size_t)pm * 256 * 2048; u.a1 = u.a0 + 128 * 2048; u.b0 = (pn < 8) ? B + (size_t)pn * 256 * 2048 : Bx; u.b1 = u.b0 + 128 * 2048; u.nt = 16; u.nt2 = 0; u.i0 = pm; u.i1 = pn; return true; }
};
template <int MODE>
struct EpiHeads { static constexpr bool PERM = false, AFTER_DRAIN = false; bf16_t* d0; bf16_t* d1; const float* ng; const float* fb; float* logf;
    __device__ __forceinline__ void operator()(const f32x4 (&acc)[2][2][4][2], const pg::GUnit& u, int wr, int wc, int fr, int fq) const {
        const int pn = u.i1, row0 = u.i0 * 256 + wr * 64 + fr;
        if (pn < 8) {
            const bool normed = pn < 4; bf16_t* dst = normed ? d0 : d1; const int col = ((pn & 3) * 4 + wc) * 64 + 16 * fq;
            float gv[16];
#pragma unroll
            for (int j = 0; j < 16; ++j) gv[j] = ng[16 * fq + j] * (MODE == 1 ? C2Q : 1.0f);
#pragma unroll
            for (int ai = 0; ai < 2; ++ai)
#pragma unroll
                for (int m = 0; m < 4; ++m) { float v[16];
#pragma unroll
                    for (int bj = 0; bj < 2; ++bj)
#pragma unroll
                        for (int n = 0; n < 2; ++n)
#pragma unroll
                            for (int j = 0; j < 4; ++j) v[8 * bj + 4 * n + j] = acc[ai][bj][m][n][j];
                    if (normed) { float ss = 0.f;
#pragma unroll
                        for (int j = 0; j < 16; ++j) ss += v[j] * v[j];
                        ss += __shfl_xor(ss, 16); ss += __shfl_xor(ss, 32);
                        const float rstd = 1.0f / sqrtf(ss * (1.0f / 64.0f) + EPS);
#pragma unroll
                        for (int j = 0; j < 16; ++j) v[j] = v[j] * rstd * gv[j]; }
                    else if (MODE == 1) {
#pragma unroll
                        for (int j = 0; j < 16; ++j) v[j] = fast_sigmoid(v[j]); }
                    u32x4 o0, o1; o0.x = pk2(v[0], v[1]); o0.y = pk2(v[2], v[3]); o0.z = pk2(v[4], v[5]); o0.w = pk2(v[6], v[7]); o1.x = pk2(v[8], v[9]); o1.y = pk2(v[10], v[11]); o1.z = pk2(v[12], v[13]); o1.w = pk2(v[14], v[15]);
                    bf16_t* p = dst + (size_t)(row0 + ai * 128 + m * 16) * D + col; *(u32x4*)p = o0; *(u32x4*)(p + 8) = o1; }
        } else if (MODE == 0) {
            if (wc != 0) return;
            float fbv[4];
#pragma unroll
            for (int j = 0; j < 4; ++j) fbv[j] = fb[4 * fq + j];
#pragma unroll
            for (int ai = 0; ai < 2; ++ai)
#pragma unroll
                for (int m = 0; m < 4; ++m) { const int row = row0 + ai * 128 + m * 16, b = row / L, t = row % L;
#pragma unroll
                    for (int j = 0; j < 4; ++j) { const float z = acc[ai][0][m][0][j] + fbv[j]; const float ls = fminf(z, 0.f) - log1pf(__expf(-fabsf(z)));
                        logf[((size_t)b * H + 4 * fq + j) * L + t] = ls; } }
        }
    }
};
struct EpiRes { static constexpr bool PERM = true, AFTER_DRAIN = false; const bf16_t* hin; const float* mod; bf16_t* hout;
    __device__ __forceinline__ void operator()(const f32x4 (&acc)[2][2][4][2], const pg::GUnit& u, int wr, int wc, int fr, int fq) const {
        const int row0 = u.i0 * 256 + wr * 64 + fr, col0 = u.i1 * 256 + wc * 32 + 8 * fq, b = (u.i0 * 256) / L;
#pragma unroll
        for (int bj = 0; bj < 2; ++bj) { const int col = col0 + bj * 128; float gt[8];
#pragma unroll
            for (int j = 0; j < 8; ++j) gt[j] = mod[b * 3072 + 2048 + col + j];
#pragma unroll
            for (int ai = 0; ai < 2; ++ai)
#pragma unroll
                for (int m = 0; m < 4; ++m) { const size_t off = (size_t)(row0 + ai * 128 + m * 16) * D + col; const u32x4 hh = *(const u32x4*)(hin + off);
                    const f32x4 a0 = acc[ai][bj][m][0], a1 = acc[ai][bj][m][1];
                    u32x4 w; w.x = pk2(bflo(hh.x) + gt[0] * a0[0], bfhi(hh.x) + gt[1] * a0[1]); w.y = pk2(bflo(hh.y) + gt[2] * a0[2], bfhi(hh.y) + gt[3] * a0[3]);
                    w.z = pk2(bflo(hh.z) + gt[4] * a1[0], bfhi(hh.z) + gt[5] * a1[1]); w.w = pk2(bflo(hh.w) + gt[6] * a1[2], bfhi(hh.w) + gt[7] * a1[3]);
                    *(u32x4*)(hout + off) = w; } }
    }
};
__global__ void __launch_bounds__(NTHR, 2) mk_fwd(Args args) {
    extern __shared__ __attribute__((aligned(16))) unsigned char lds_raw[];
    Frame F;
    F.lds = (LAS unsigned char*)lds_raw; F.ws = args.ws; F.in = args.in; F.out = args.out;
    F.tid = threadIdx.x; F.lane = F.tid & 63; F.wave = __builtin_amdgcn_readfirstlane(F.tid >> 6);
    F.G = gridDim.x; { const int bx = blockIdx.x; F.vcu = (F.G % 8 == 0) ? (bx % 8) * (F.G / 8) + bx / 8 : bx; }
    unsigned char* ws = args.ws;
    unsigned* ctl = (unsigned*)(ws + WS_CTL);
    volatile LAS unsigned* MISC = (volatile LAS unsigned*)(F.lds + MISC_OFF);
    for (int u = F.tid; u < (LDS_BYTES - LDSCTL_OFF) / 4; u += NTHR) ((LAS unsigned*)(F.lds + LDSCTL_OFF))[u] = 0u;
    __syncthreads();
    const int lo = args.ph_lo, hi = args.ph_hi;
    const bool multi = (hi - lo) > 1;
    XcdBarrier bar; bar.bar = ctl + CW_BAR; bar.x = 0; bar.st = nullptr;
    if (multi) bar = xcd_barrier_post(ctl + CW_BAR, MISC + 8);
#define IN(k) (lo <= (k) && (k) < hi)
#define SEAM(k) do { if (IN(k) && IN((k) + 1)) xcd_barrier(bar); } while (0)
    float* mods = (float*)(ws + WS_MODS);
    bf16_t* S0 = (bf16_t*)(ws + SLOTP(0)); bf16_t* S1 = (bf16_t*)(ws + SLOTP(1)); bf16_t* S2 = (bf16_t*)(ws + SLOTP(2)); bf16_t* S3 = (bf16_t*)(ws + SLOTP(3)); bf16_t* S4 = (bf16_t*)(ws + SLOTP(4)); bf16_t* S5 = (bf16_t*)(ws + SLOTP(5));
    (void)S5;
    if (IN(0)) { p0_mods(F); __syncthreads(); p0_convert(F); __syncthreads(); p0_s5_tables(F); }
    SEAM(0);
    if (IN(1)) rows_norm_mod<true>(F, F.in[I_X], F.in[I_LNG], mods, S0);
    SEAM(1);
    if (IN(2)) { SchedDense S; S.o.init(T, D, F.G, (int)blockIdx.x); S.A = (const char*)S0; S.B = (const char*)(ws + WS_BT_IN); S.apitch = 2048; S.bpitch = 2048; S.nt = 16;
        EpiToGM E{S1}; pg::KStep ks{128, 128, 0, 0}; pg::LaneOff lo_{}; pg::lane_off_rowmajor(lo_.a, 2048, false); pg::lane_off_rowmajor(lo_.b, 2048, true);
        pg::gemm_phase<EpiToGM, SchedDense, false, false, true>(F.lds, S, E, ks, lo_, 0); }
    SEAM(2);
    if (IN(3)) { SchedE S{F.vcu, F.G, (const char*)S1, (const char*)(ws + WS_WB)};
        EpiScan E{S3, (const f32x2*)(ws + WS_A64)}; pg::KStep ks{128, 128, 0, 0}; pg::LaneOff lo_{}; pg::lane_off_rowmajor(lo_.a, 2048, false); pg::lane_off_rowmajor(lo_.b, 2048, false);
        pg::gemm_phase<EpiScan, SchedE, false, false, false>(F.lds, S, E, ks, lo_, 0); }
    SEAM(3);
    if (IN(4)) { SchedY S{F.vcu, F.G, (const char*)S1, (const char*)S3, (const char*)(ws + WS_KTAB), (const char*)(ws + WS_VT)};
        EpiY E{S1, S2, F.in[I_DSK]}; pg::KStep ks{128, -2048, 128, 128}; pg::LaneOff lo_{};
        pg::lane_off_rowmajor(lo_.a, 2048, false); pg::lane_off_rowmajor(lo_.a2, 256, false); pg::lane_off_rowmajor(lo_.b2, 256, true);
#pragma unroll
        for (int i = 0; i < 2; ++i) { int R, C; int tq = threadIdx.x; asm volatile("" : "+v"(tq)); pg::stage_rc(tq * 16 + i * 8192, R, C); const int Rb = (R & ~31) + pg::perm32(R & 31); lo_.b[i] = (((Rb >> 4) - (C >> 4)) * 256 + (Rb & 15) * 16 + (C & 15)) * 2; }
        pg::gemm_phase<EpiY, SchedY, true, false, true>(F.lds, S, E, ks, lo_, 0); }
    SEAM(4);
    if (IN(5)) { SchedOut S; S.o.init(T, 2048, F.G, (int)blockIdx.x); S.Y = (const char*)S2; S.B = (const char*)(ws + WS_BT_OUT);
        EpiGluRes E{F.in[I_X], mods, S4}; pg::KStep ks{(long)4 * T * 32, 128, 0, 0}; pg::LaneOff lo_{}; pg::lane_off_rowmajor(lo_.b, 2048, true);
#pragma unroll
        for (int i = 0; i < 2; ++i) { int R, C; int tq = threadIdx.x; asm volatile("" : "+v"(tq)); pg::stage_rc(tq * 16 + i * 8192, R, C); lo_.a[i] = R * 32 + (C >> 4) * (T * 32) + (C & 15) * 2; }
        pg::gemm_phase<EpiGluRes, SchedOut, false, false, true>(F.lds, S, E, ks, lo_, 0); }
    SEAM(5);
    if (IN(6)) rows_norm_mod<false>(F, S4, F.in[I_LNG] + D, mods + 1 * NB * 3072, S0);
    SEAM(6);
    if (IN(7)) ph_route(F, 0, S0);
    SEAM(7);
    if (IN(8)) ph_moe_up(F, 0, S0, S1);
    SEAM(8);
    if (IN(9)) ph_moe_down(F, 0, S1, S2, S3);
    SEAM(9);
    if (IN(10)) rows_combine<false, 2>(F, S4, S2, S3, mods + 1 * NB * 3072, S5, nullptr, F.in[I_KVG], mods + 4 * NB * 3072, S1, F.in[I_LNG] + 2 * D, mods + 2 * NB * 3072, S0);
    SEAM(10);
    if (IN(11)) { SchedHeads S; S.o.init(T, 9 * 256, F.G, (int)blockIdx.x); S.A = (const char*)S1; S.B = (const char*)(ws + WS_BT_KV); S.Bx = (const char*)(ws + WS_BT_FZ);
        EpiHeads<0> E{S2, S3, F.in[I_KNG], F.in[I_KVFB], (float*)(ws + WS_LOGF)}; pg::KStep ks{128, 128, 0, 0}; pg::LaneOff lo_{}; pg::lane_off_rowmajor(lo_.a, 2048, false); pg::lane_off_rowmajor(lo_.b, 2048, false);
        pg::gemm_phase<EpiHeads<0>, SchedHeads, false, false, true>(F.lds, S, E, ks, lo_, 0); }
    SEAM(11);
    if (IN(12)) { SchedHeads S; S.o.init(T, 8 * 256, F.G, (int)blockIdx.x); S.A = (const char*)S0; S.B = (const char*)(ws + WS_BT_QG); S.Bx = S.B;
        EpiHeads<1> E{S1, S4, F.in[I_QNG], nullptr, nullptr}; pg::KStep ks{128, 128, 0, 0}; pg::LaneOff lo_{}; pg::lane_off_rowmajor(lo_.a, 2048, false); pg::lane_off_rowmajor(lo_.b, 2048, false);
        pg::gemm_phase<EpiHeads<1>, SchedHeads, false, false, true>(F.lds, S, E, ks, lo_, 0); }
    SEAM(12);
    if (IN(13)) { const attn_body::AttnTensors AT{(const attn_body::bf16*)S1, (const attn_body::bf16*)S2, (const attn_body::bf16*)S3, (attn_body::bf16*)S1, (const attn_body::bf16*)S4, (const float*)(ws + WS_LOGF)};
        const attn_body::StaticOrder S((int)F.G, F.vcu);
        attn_body::attn_phase<attn_body::StaticOrder>((char*)lds_raw, AT, S); }
    SEAM(13);
    if (IN(14)) { SchedDense S; S.o.init(T, D, F.G, (int)blockIdx.x); S.A = (const char*)S1; S.B = (const char*)(ws + WS_BT_O); S.apitch = 2048; S.bpitch = 2048; S.nt = 16;
        EpiRes E{S5, mods + 2 * NB * 3072, S4}; pg::KStep ks{128, 128, 0, 0}; pg::LaneOff lo_{}; pg::lane_off_rowmajor(lo_.a, 2048, false); pg::lane_off_rowmajor(lo_.b, 2048, true);
        pg::gemm_phase<EpiRes, SchedDense, false, false, true>(F.lds, S, E, ks, lo_, 0); }
    SEAM(14);
    if (IN(15)) rows_norm_mod<false>(F, S4, F.in[I_LNG] + 3 * D, mods + 3 * NB * 3072, S0);
    SEAM(15);
    if (IN(16)) ph_route(F, 1, S0);
    SEAM(16);
    if (IN(17)) ph_moe_up(F, 1, S0, S1);
    SEAM(17);
    if (IN(18)) ph_moe_down(F, 1, S1, S2, S3);
    SEAM(18);
    if (IN(19)) rows_combine<true, 0>(F, S4, S2, S3, mods + 3 * NB * 3072, nullptr, F.out, nullptr, nullptr, nullptr, nullptr, nullptr, nullptr);
#undef IN
#undef SEAM
}
}
#ifndef ONE_LAUNCH
#define ONE_LAUNCH 1
#endif
extern "C" void kernel_launch(void* const* d_in, const int* in_sizes, int n_in, void* d_out, int out_size, void* d_ws, size_t ws_size, hipStream_t stream) {
    static int grid = 0;
    if (grid == 0) {
        if (n_in != 31 || out_size != mk::T * mk::D || ws_size < mk::WS_END) { fprintf(stderr, "kernel_launch: unexpected shapes / workspace (n_in %d, out %d, ws %zu < %zu)\n", n_in, out_size, ws_size, (size_t)mk::WS_END); grid = -1; return; }
        int dev = 0, cus = 0, per_cu = 0;
        if (hipGetDevice(&dev) != hipSuccess || hipDeviceGetAttribute(&cus, hipDeviceAttributeMultiprocessorCount, dev) != hipSuccess) { grid = -1; return; }
        if (hipFuncSetAttribute((const void*)mk::mk_fwd, hipFuncAttributeMaxDynamicSharedMemorySize, mk::LDS_BYTES) != hipSuccess) { fprintf(stderr, "kernel_launch: hipFuncSetAttribute failed\n"); grid = -1; return; }
        if (hipOccupancyMaxActiveBlocksPerMultiprocessor(&per_cu, (const void*)mk::mk_fwd, mk::NTHR, mk::LDS_BYTES) != hipSuccess || per_cu < 1) { fprintf(stderr, "kernel_launch: occupancy query says %d workgroups per CU\n", per_cu); grid = -1; (void)hipGetLastError(); return; }
        grid = cus;
    }
    if (grid < 0) return;
    (void)hipMemsetAsync((char*)d_ws + mk::WS_CTL, 0, mk::CTL_ZERO_BYTES, stream);
    mk::Args a{};
    for (int i = 0; i < 31; ++i) a.in[i] = (const float*)d_in[i];
    a.out = (float*)d_out; a.ws = (unsigned char*)d_ws;
    constexpr int NPH = 20;
#if ONE_LAUNCH
    a.ph_lo = 0; a.ph_hi = NPH; hipLaunchKernelGGL(mk::mk_fwd, dim3(grid), dim3(mk::NTHR), mk::LDS_BYTES, stream, a);
#else
    for (int p = 0; p < NPH; ++p) { a.ph_lo = p; a.ph_hi = p + 1; hipLaunchKernelGGL(mk::mk_fwd, dim3(grid), dim3(mk::NTHR), mk::LDS_BYTES, stream, a); }
#endif
}
```

```cpp
#define ONE_LAUNCH 1
#include <hip/hip_runtime.h>
#include <hip/hip_bf16.h>
#include <cstdint>
#include <cstdio>
namespace attn_body {
using bf16=__hip_bfloat16;
using bf16x8=__attribute__((ext_vector_type(8)))short;
using s16x4=__attribute__((ext_vector_type(4)))short;
using f32x16=__attribute__((ext_vector_type(16)))float;
using u32x4=__attribute__((ext_vector_type(4)))unsigned;
constexpr int BATCH=8,NHEAD=16,SEQ=4096,D=64,DM=NHEAD*D;
constexpr int NW=8,QBLK=32,QB=QBLK*NW,KVBLK=64,NQB=SEQ/QB;
constexpr int ATTN_PITCH=DM, ATTN_UNIT_ROWS=QB;
__device__ __forceinline__ int crow(int r,int hi){return (r&3)+8*(r>>2)+4*hi;}
#define SBAR() __builtin_amdgcn_sched_barrier(0)
__device__ __forceinline__ void cmask(f32x16&p0,f32x16&p1,int jb,int qrel,int hi){
  const float NEG=-INFINITY; int kb=64*jb+4*hi;
  #pragma unroll
  for(int r=0;r<16;++r){int kv=kb+(r&3)+8*(r>>2); if(kv>qrel)p0[r]=NEG; if(kv+32>qrel)p1[r]=NEG;}
}

constexpr int NSLOT=3, SLOTB=8192;
constexpr int LDS_K=0, LDS_V=NSLOT*SLOTB, LDS_WS=2*NSLOT*SLOTB, LDS_OST=LDS_WS+NW*64*4, LDS_FL=LDS_OST+NW*4096, LDS_KX=LDS_FL+SEQ*4, LDS_BYTES=LDS_KX+SEQ*8;
constexpr float C2=0.125f*1.4426950408889634f;
__device__ __forceinline__ void glds16s(const void*gbase,unsigned voff,unsigned lds_dst){unsigned keep;
  asm volatile("s_mov_b32 %0, m0\n\ts_mov_b32 m0, %3\n\ts_nop 0\n\tglobal_load_lds_dwordx4 %1, %2\n\ts_mov_b32 m0, %0":"=&s"(keep):"v"(voff),"s"(gbase),"s"(lds_dst):"memory");}
__device__ __forceinline__ void glds16(const void*gsrc,unsigned lds_dst){unsigned keep;
  asm volatile("s_mov_b32 %0, m0\n\ts_mov_b32 m0, %2\n\ts_nop 0\n\tglobal_load_lds_dwordx4 %1, off\n\ts_mov_b32 m0, %0":"=&s"(keep):"v"(gsrc),"s"(lds_dst):"memory");}
__device__ __forceinline__ float max3f(float a,float b,float c){float r;asm("v_max3_f32 %0, %1, %2, %3":"=v"(r):"v"(a),"v"(b),"v"(c));return r;}
__device__ __forceinline__ float max2f(float a,float b){float r;asm("v_max_f32_e32 %0, %1, %2":"=v"(r):"v"(a),"v"(b));return r;}
__device__ __forceinline__ float fadd_s(float a,float b){float r;asm("v_add_f32_e32 %0, %1, %2":"=v"(r):"v"(a),"v"(b));return r;}
__device__ __forceinline__ float fsub_s(float a,float b){float r;asm("v_sub_f32_e32 %0, %1, %2":"=v"(r):"v"(a),"v"(b));return r;}
typedef unsigned u32x2_t __attribute__((ext_vector_type(2)));
__device__ __forceinline__ unsigned bfr(float f){unsigned u=__builtin_bit_cast(unsigned,f);return (u+0x7fffu+((u>>16)&1u))>>16;}
__device__ __forceinline__ void split3(float x,unsigned&h0,unsigned&h1,unsigned&h2){h0=bfr(x);const float r1=x-__builtin_bit_cast(float,h0<<16);h1=bfr(r1);const float r2=r1-__builtin_bit_cast(float,h1<<16);h2=bfr(r2);}
typedef float f32x2_t __attribute__((ext_vector_type(2))); typedef float f32x4_t __attribute__((ext_vector_type(4))); typedef __bf16 bf16x2_t __attribute__((ext_vector_type(2)));
__device__ __forceinline__ unsigned cvtpk_s(float lo,float hi){f32x2_t v={lo,hi};bf16x2_t b=__builtin_convertvector(v,bf16x2_t);return __builtin_bit_cast(unsigned,b);}
#define WAIT_BAR(N) asm volatile("s_waitcnt vmcnt(" #N ") lgkmcnt(0)\n\ts_barrier":::"memory")

__device__ __forceinline__ void qkt(f32x16&p0,f32x16&p1,const char*Kslot,const bf16x8*qr,int r32,int hi){
  const char*kb=Kslot+hi*1024+r32*16;
  #pragma unroll
  for(int d0=0;d0<4;++d0){
    const bf16x8 b0=*reinterpret_cast<const bf16x8*>(kb+d0*2048);
    const bf16x8 b1=*reinterpret_cast<const bf16x8*>(kb+d0*2048+512);
    p0=__builtin_amdgcn_mfma_f32_32x32x16_bf16(b0,qr[d0],p0,0,0,0);p1=__builtin_amdgcn_mfma_f32_32x32x16_bf16(b1,qr[d0],p1,0,0,0);}
}
typedef __attribute__((address_space(3))) const char* lds_cptr;
typedef short v4i16_t __attribute__((ext_vector_type(4)));
__device__ __forceinline__ void kload8(bf16x8*kf,lds_cptr kp){
  kf[0]=*(const __attribute__((address_space(3))) bf16x8*)(kp);      kf[1]=*(const __attribute__((address_space(3))) bf16x8*)(kp+512);
  kf[2]=*(const __attribute__((address_space(3))) bf16x8*)(kp+2048); kf[3]=*(const __attribute__((address_space(3))) bf16x8*)(kp+2560);
  kf[4]=*(const __attribute__((address_space(3))) bf16x8*)(kp+4096); kf[5]=*(const __attribute__((address_space(3))) bf16x8*)(kp+4608);
  kf[6]=*(const __attribute__((address_space(3))) bf16x8*)(kp+6144); kf[7]=*(const __attribute__((address_space(3))) bf16x8*)(kp+6656);
}
__device__ __forceinline__ void kload2(bf16x8*kf,lds_cptr kp,int j){ kf[2*j]=*(const __attribute__((address_space(3))) bf16x8*)(kp+j*2048); kf[2*j+1]=*(const __attribute__((address_space(3))) bf16x8*)(kp+j*2048+512); }
__device__ __forceinline__ s16x4 vtr(lds_cptr p){ return __builtin_bit_cast(s16x4,__builtin_amdgcn_ds_read_tr16_b64_v4i16((__attribute__((address_space(3))) v4i16_t*)p)); }
__device__ __forceinline__ float rowmax(const f32x16&p0,const f32x16&p1){
  float a=max3f(p0[0],p0[1],p1[0]),b=max3f(p0[2],p0[3],p1[1]);a=max3f(a,p1[2],p1[3]);
  #pragma unroll
  for(int r=4;r<16;r+=4){a=max3f(a,p0[r],p0[r+1]);b=max3f(b,p0[r+2],p0[r+3]);a=max3f(a,p1[r],p1[r+1]);b=max3f(b,p1[r+2],p1[r+3]);}
  const float m=max2f(a,b);
  auto rr=__builtin_amdgcn_permlane32_swap(__float_as_uint(m),__float_as_uint(m),false,false);
  return max2f(__uint_as_float(rr[0]),__uint_as_float(rr[1]));
}
__device__ __forceinline__ void pv(f32x16*o,int vb,bf16x8 pa0,bf16x8 pa1,bf16x8 pa2,bf16x8 pa3){
  #pragma unroll
  for(int d0=0;d0<2;++d0){s16x4 lo[4],hi[4];
    #pragma unroll
    for(int ks=0;ks<4;++ks){
      asm volatile("ds_read_b64_tr_b16 %0,%1 offset:%c2":"=&v"(lo[ks]):"v"(vb),"i"(d0*4096+ks*1024):"memory");
      asm volatile("ds_read_b64_tr_b16 %0,%1 offset:%c2":"=&v"(hi[ks]):"v"(vb),"i"(d0*4096+ks*1024+512):"memory");}
    asm volatile("s_waitcnt lgkmcnt(0)":::"memory");SBAR();
    #define PK(k) (bf16x8){lo[k][0],lo[k][1],lo[k][2],lo[k][3],hi[k][0],hi[k][1],hi[k][2],hi[k][3]}
    o[d0]=__builtin_amdgcn_mfma_f32_32x32x16_bf16(pa0,PK(0),o[d0],0,0,0);
    o[d0]=__builtin_amdgcn_mfma_f32_32x32x16_bf16(pa1,PK(1),o[d0],0,0,0);
    o[d0]=__builtin_amdgcn_mfma_f32_32x32x16_bf16(pa2,PK(2),o[d0],0,0,0);
    o[d0]=__builtin_amdgcn_mfma_f32_32x32x16_bf16(pa3,PK(3),o[d0],0,0,0);
    #undef PK
  }
}

#ifndef ATTN_STORE16
#define ATTN_STORE16(p,v) (*(u32x4*)(p)=(v))
#endif
template<int THRL> __device__ __forceinline__ void attn_unit(int b,int h,int qb,const bf16*Q,const bf16*__restrict__ K,const bf16*__restrict__ V,bf16*O,const bf16*__restrict__ Gt,char*shm,const float qbound,const float skip_thr){
  int tid=threadIdx.x; asm volatile("":"+v"(tid)); const int lane=tid&63,r32=lane&31,hi=lane>>5; const int wid=__builtin_amdgcn_readfirstlane(tid>>6);
  const long rowbase=(long)b*SEQ; const int q0=qb*QB;
  const bf16*Qw=Q+(rowbase+q0+wid*QBLK)*DM+h*D;
  const bf16*Kh=K+rowbase*DM+h*D,*Vh=V+rowbase*DM+h*D;
  const unsigned lds0=(unsigned)(uintptr_t)shm;
  float*wsf=(float*)(shm+LDS_WS)+wid*64;
  const unsigned koff=(unsigned)((lane*DM+wid*8)*2);
  const unsigned voff=(unsigned)(((16*(wid&3)+(lane>>2))*DM+(wid>>2)*32+(lane&3)*8)*2);
  const unsigned kdst=lds0+LDS_K+wid*1024, vdst=lds0+LDS_V+wid*1024;
  #define DMA_K(t,slot) glds16s(Kh,koff+(unsigned)(t)*(unsigned)(KVBLK*DM*2),(unsigned)__builtin_amdgcn_readfirstlane(kdst+(slot)))
  #define DMA_V(t,slot) glds16s(Vh,voff+(unsigned)(t)*(unsigned)(KVBLK*DM*2),(unsigned)__builtin_amdgcn_readfirstlane(vdst+(slot)))
  const int vb0=(int)(lds0+LDS_V)+((lane>>4)&1)*32+(lane&3)*8+(4*hi+((lane&15)>>2))*64;
  const char*Kbase=shm+LDS_K; bf16x8 kf[8];
  const lds_cptr shm3=(lds_cptr)shm; const lds_cptr kp0=shm3+LDS_K+hi*1024+r32*16; const lds_cptr vp0=shm3+LDS_V+((lane>>4)&1)*32+(lane&3)*8+(4*hi+((lane&15)>>2))*64;
  const float*flt=(const float*)(shm+LDS_FL);
  const float mhat=flt[q0+wid*QBLK+r32]+qbound;
  int NT=(q0+QB)/KVBLK;
  int tb_;
  { const bool need=(lane<NT)&&(flt[q0]-flt[lane*KVBLK+KVBLK-1]<=skip_thr); const unsigned long long bal=__ballot(need);
    int tb=bal?(int)__builtin_ctzll(bal):NT-4; tb&=~1; if(tb>NT-4)tb=NT-4; tb=__builtin_amdgcn_readfirstlane(tb);
    Kh+=(long)tb*KVBLK*DM; Vh+=(long)tb*KVBLK*DM; NT-=tb; tb_=tb; }
  DMA_K(0,0);DMA_V(0,0);DMA_K(1,SLOTB);
  bf16x8 qr[4];
  #pragma unroll
  for(int d0=0;d0<4;++d0)qr[d0]=*reinterpret_cast<const bf16x8*>(&Qw[(long)r32*DM+d0*16+hi*8]);
  float l_reg=0.f;f32x16 o[2];o[0]=f32x16{};o[1]=f32x16{};const f32x16 zz={};
  const int qrel=wid*QBLK+r32;
  #define CMASK(P0,P1,t) do{int jb_=(t)-(NT-4); if(jb_>=0)cmask(P0,P1,jb_,qrel,hi);}while(0)
  bf16x8 qx; { unsigned h0,h1,h2; split3(-mhat,h0,h1,h2); u32x4 w; w.x=0x3f803f80u; w.y=0x3f80u|(h0<<16); w.z=h1|(h2<<16); w.w=0u; if(hi){w.x=0u;w.y=0u;w.z=0u;} qx=__builtin_bit_cast(bf16x8,w); }
  const lds_cptr kxp=(lds_cptr)shm+LDS_KX+(tb_+0)*512+r32*8;
  #define KXF(x) __builtin_bit_cast(bf16x8,(u32x4){(x)[0],(x)[1],0x3f803f80u,0u})
  #define KXLD(t,X0,X1) const u32x2_t X0=*(const __attribute__((address_space(3))) u32x2_t*)(kxp+(t)*512), X1=*(const __attribute__((address_space(3))) u32x2_t*)(kxp+(t)*512+256)
  #define START(P0,P1) do{ _Pragma("unroll") for(int r=0;r<16;++r)P0[r]=__builtin_amdgcn_exp2f(P0[r]); }while(0)
  f32x16 pA0,pA1,pB0,pB1;
  int sl_prev=0,sl_cur=0,sl_next=SLOTB;
  #define ROT() do{sl_prev=sl_cur;sl_cur=sl_next;sl_next=(sl_next==(NSLOT-1)*SLOTB)?0:sl_next+SLOTB;}while(0)
  DMA_K(2,2*SLOTB);
  WAIT_BAR(3);
  { KXLD(0,x0_,x1_); pA0=__builtin_amdgcn_mfma_f32_32x32x16_bf16(KXF(x0_),qx,zz,0,0,0); pA1=__builtin_amdgcn_mfma_f32_32x32x16_bf16(KXF(x1_),qx,zz,0,0,0); }
  qkt(pA0,pA1,Kbase,qr,r32,hi);asm volatile("s_nop 15\n\ts_nop 7":"+v"(pA0),"+v"(pA1));CMASK(pA0,pA1,0);
  START(pA0,pA1);
  _Pragma("unroll") for(int r=0;r<16;++r)pA1[r]=__builtin_amdgcn_exp2f(pA1[r]);
  WAIT_BAR(0);
  DMA_K(3,0);DMA_V(1,SLOTB);
  ROT();
  kload8(kf,kp0+sl_cur);
  WAIT_BAR(2);
  s16x4 vlo[8],vhi[8]; u32x4 pw0,pw1,pw2,pw3;
  #define PKW(P,B) cvtpk_s(P[B],P[B+1])
  #define PAF(k) __builtin_bit_cast(bf16x8,pw##k)
  #define VFR(i) (bf16x8){vlo[i][0],vlo[i][1],vlo[i][2],vlo[i][3],vhi[i][0],vhi[i][1],vhi[i][2],vhi[i][3]}
  #define PIN(x) asm volatile("":"+v"(x))
  #define MX3(a,b,c) __builtin_fmaxf(__builtin_fmaxf((a),(b)),(c))
  #define GAPA(MF,A0,A1,A2,A3,W0,W1,PW) do{ MF; sacc+=A0; sacc+=A1; sacc+=A2; sacc+=A3; PIN(sacc); W0; W1; PIN(PW); SBAR(); }while(0)
  #define EX(v) __builtin_amdgcn_exp2f(v)
  #define GAPB(MF,X,B) do{ MF; X[B]=EX(X[B]); X[B+1]=EX(X[B+1]); X[B+2]=EX(X[B+2]); X[B+3]=EX(X[B+3]); PIN(X); SBAR(); }while(0)
  #define VRD(i) do{ vlo[i]=vtr(vp_+(((i)>>2)*4096+((i)&3)*1024)); vhi[i]=vtr(vp_+(((i)>>2)*4096+((i)&3)*1024+512)); }while(0)
  #define KRD(G,j) do{ if(G){ kload2(kf,kp0+sl_next,j); SBAR(); } }while(0)
  #define STEP(C0,C1,P0,P1,t,GK,GV,GL) do{ SBAR(); \
    const lds_cptr vp_=vp0+sl_prev; \
    KXLD(t,x0_,x1_); VRD(0); SBAR(); float sacc=(P0[0]+P0[1]); \
    C0=__builtin_amdgcn_mfma_f32_32x32x16_bf16(KXF(x0_),qx,zz,0,0,0); C1=__builtin_amdgcn_mfma_f32_32x32x16_bf16(KXF(x1_),qx,zz,0,0,0); SBAR(); \
    GAPA(C0=__builtin_amdgcn_mfma_f32_32x32x16_bf16(kf[0],qr[0],C0,0,0,0), P0[2],P0[3],P0[4],P0[5],     pw0[0]=PKW(P0,0), pw0[1]=PKW(P0,2), pw0); \
    VRD(4); SBAR(); GAPA(C1=__builtin_amdgcn_mfma_f32_32x32x16_bf16(kf[1],qr[0],C1,0,0,0), P0[6],P0[7],P0[8],P0[9],     pw0[2]=PKW(P0,4), pw0[3]=PKW(P0,6), pw0); \
    VRD(1); SBAR(); GAPA(C0=__builtin_amdgcn_mfma_f32_32x32x16_bf16(kf[2],qr[1],C0,0,0,0),   P0[10],P0[11],P0[12],P0[13], pw1[0]=PKW(P0,8), pw1[1]=PKW(P0,10), pw1); \
    VRD(5); SBAR(); GAPA(C1=__builtin_amdgcn_mfma_f32_32x32x16_bf16(kf[3],qr[1],C1,0,0,0),   P0[14],P0[15],P1[0],P1[1],   pw1[2]=PKW(P0,12),pw1[3]=PKW(P0,14), pw1); \
    VRD(2); SBAR(); GAPA(C0=__builtin_amdgcn_mfma_f32_32x32x16_bf16(kf[4],qr[2],C0,0,0,0),   P1[2],P1[3],P1[4],P1[5],     pw2[0]=PKW(P1,0), pw2[1]=PKW(P1,2), pw2); \
    VRD(6); SBAR(); GAPA(C1=__builtin_amdgcn_mfma_f32_32x32x16_bf16(kf[5],qr[2],C1,0,0,0),   P1[6],P1[7],P1[8],P1[9],     pw2[2]=PKW(P1,4), pw2[3]=PKW(P1,6), pw2); \
    VRD(3); SBAR(); GAPA(C0=__builtin_amdgcn_mfma_f32_32x32x16_bf16(kf[6],qr[3],C0,0,0,0),   P1[10],P1[11],P1[12],P1[13], pw3[0]=PKW(P1,8), pw3[1]=PKW(P1,10), pw3); \
    VRD(7); SBAR(); GAPA(C1=__builtin_amdgcn_mfma_f32_32x32x16_bf16(kf[7],qr[3],C1,0,0,0),   P1[14],P1[15],0.f,0.f,       pw3[2]=PKW(P1,12),pw3[3]=PKW(P1,14), pw3); \
    l_reg+=sacc; \
    if(GK){DMA_K((t)+3,sl_cur);} if(GV){DMA_V((t)+1,sl_next);} \
    CMASK(C0,C1,t); \
    SBAR(); \
    GAPB(o[0]=__builtin_amdgcn_mfma_f32_32x32x16_bf16(PAF(0),VFR(0),o[0],0,0,0), C0,0); \
    GAPB(o[1]=__builtin_amdgcn_mfma_f32_32x32x16_bf16(PAF(0),VFR(4),o[1],0,0,0), C0,4); \
    KRD(GL,0); GAPB(o[0]=__builtin_amdgcn_mfma_f32_32x32x16_bf16(PAF(1),VFR(1),o[0],0,0,0), C0,8); \
    KRD(GL,1); GAPB(o[1]=__builtin_amdgcn_mfma_f32_32x32x16_bf16(PAF(1),VFR(5),o[1],0,0,0), C0,12); \
    KRD(GL,2); GAPB(o[0]=__builtin_amdgcn_mfma_f32_32x32x16_bf16(PAF(2),VFR(2),o[0],0,0,0), C1,0); \
    KRD(GL,3); GAPB(o[1]=__builtin_amdgcn_mfma_f32_32x32x16_bf16(PAF(2),VFR(6),o[1],0,0,0), C1,4); \
    GAPB(o[0]=__builtin_amdgcn_mfma_f32_32x32x16_bf16(PAF(3),VFR(3),o[0],0,0,0), C1,8); \
    GAPB(o[1]=__builtin_amdgcn_mfma_f32_32x32x16_bf16(PAF(3),VFR(7),o[1],0,0,0), C1,12); \
    }while(0)
  int t=1;
  #undef CMASK
  #define CMASK(P0,P1,t) do{}while(0)
  for(;t+5<NT;t+=2){
    STEP(pB0,pB1,pA0,pA1,t,true,true,true);     WAIT_BAR(2); ROT();
    STEP(pA0,pA1,pB0,pB1,t+1,true,true,true);   WAIT_BAR(2); ROT();
  }
  #undef CMASK
  #define CMASK(P0,P1,t) do{int jb_=(t)-(NT-4); if(jb_>=0)cmask(P0,P1,jb_,qrel,hi);}while(0)
  #define ENDW(tt) do{ if((tt)+3<NT){WAIT_BAR(2);} else if((tt)+2<NT){WAIT_BAR(1);} else {WAIT_BAR(0);} }while(0)
  for(;t+1<NT;t+=2){
    STEP(pB0,pB1,pA0,pA1,t,(t+3<NT),(t+1<NT),(t+1<NT));       ENDW(t);   ROT();
    STEP(pA0,pA1,pB0,pB1,t+1,(t+4<NT),(t+2<NT),(t+2<NT));     ENDW(t+1); ROT();
  }
  STEP(pB0,pB1,pA0,pA1,NT-1,false,false,false);
  { float sacc=pB0[0]+pB0[1]; _Pragma("unroll") for(int r=2;r<16;++r)sacc+=pB0[r]; _Pragma("unroll") for(int r=0;r<16;++r)sacc+=pB1[r]; l_reg+=sacc;
    pw0=(u32x4){PKW(pB0,0),PKW(pB0,2),PKW(pB0,4),PKW(pB0,6)};pw1=(u32x4){PKW(pB0,8),PKW(pB0,10),PKW(pB0,12),PKW(pB0,14)};pw2=(u32x4){PKW(pB1,0),PKW(pB1,2),PKW(pB1,4),PKW(pB1,6)};pw3=(u32x4){PKW(pB1,8),PKW(pB1,10),PKW(pB1,12),PKW(pB1,14)};
    SBAR(); pv(o,vb0+sl_cur,PAF(0),PAF(1),PAF(2),PAF(3)); }
  #undef PKW
  #undef PAF
  #undef VFR
  #undef PIN
  #undef MX3
  #undef GAPA
  #undef GAPB
  #undef EX
  #undef VRD
  #undef KRD
  #undef STEP
  #undef ENDW
  {auto rr=__builtin_amdgcn_permlane32_swap(__float_as_uint(l_reg),__float_as_uint(l_reg),false,false);l_reg=__uint_as_float(rr[0])+__uint_as_float(rr[1]);}
  if(hi==0)wsf[32+r32]=l_reg;asm volatile("s_waitcnt lgkmcnt(0)":::"memory");
  float rli[16];
  #pragma unroll
  for(int r=0;r<16;++r)rli[r]=__builtin_amdgcn_rcpf(wsf[32+crow(r,hi)]);
  bf16*Ow=O+(rowbase+q0+wid*QBLK)*DM+h*D;
  { bf16*stg=(bf16*)(shm+LDS_OST)+wid*2048;
    #pragma unroll
    for(int r=0;r<16;++r){const int orow=crow(r,hi);
      #pragma unroll
      for(int d0=0;d0<2;++d0)stg[orow*64+d0*32+r32]=__float2bfloat16(o[d0][r]*rli[r]);}
    asm volatile("s_waitcnt lgkmcnt(0)":::"memory");
    const bf16*Gw=Gt+(rowbase+q0+wid*QBLK)*DM+h*D;
    #pragma unroll
    for(int i=0;i<4;++i){const int row=i*8+(lane>>3),ch=lane&7; const u32x4 v=*(const u32x4*)(stg+row*64+ch*8); const u32x4 gg=*(const u32x4*)(Gw+(long)row*DM+ch*8); u32x4 w;
      w.x=cvtpk_s(__builtin_bit_cast(float,v.x<<16)*__builtin_bit_cast(float,gg.x<<16),__builtin_bit_cast(float,v.x&0xffff0000u)*__builtin_bit_cast(float,gg.x&0xffff0000u));
      w.y=cvtpk_s(__builtin_bit_cast(float,v.y<<16)*__builtin_bit_cast(float,gg.y<<16),__builtin_bit_cast(float,v.y&0xffff0000u)*__builtin_bit_cast(float,gg.y&0xffff0000u));
      w.z=cvtpk_s(__builtin_bit_cast(float,v.z<<16)*__builtin_bit_cast(float,gg.z<<16),__builtin_bit_cast(float,v.z&0xffff0000u)*__builtin_bit_cast(float,gg.z&0xffff0000u));
      w.w=cvtpk_s(__builtin_bit_cast(float,v.w<<16)*__builtin_bit_cast(float,gg.w<<16),__builtin_bit_cast(float,v.w&0xffff0000u)*__builtin_bit_cast(float,gg.w&0xffff0000u));
      ATTN_STORE16(Ow+(long)row*DM+ch*8,w);} }
  asm volatile("s_waitcnt lgkmcnt(0)\n\ts_barrier":::"memory");
  #undef DMA_K
  #undef DMA_V
  #undef CMASK
  #undef KXF
  #undef KXLD
  #undef START
  #undef ROT
}
constexpr int ATTN_LDS_BYTES=LDS_BYTES;
struct AttnTensors { const bf16* Q; const bf16* K; const bf16* V; bf16* O; const bf16* G; const float* logf; };
struct AttnUnit { int bh; int qb; };
struct StaticOrder {
  int vcu, G;
  __device__ __forceinline__ explicit StaticOrder(int grid,int v):vcu(v),G(grid){}
  __device__ __forceinline__ bool next(int i,AttnUnit&u)const{
    if(G==256){ if(i>=8)return false; const int s=(vcu&1)*4+(i>>1); u.bh=vcu>>1; u.qb=(i&1)?15-s:s; return true; }
    const int U=i*G+vcu; if(U>=BATCH*NHEAD*NQB)return false; u.bh=U/NQB; u.qb=U%NQB; return true; }
};
__device__ __forceinline__ void build_forget_table(char*lds,const float*logf_bh){
  const int tid=threadIdx.x,lane=tid&63,wid=tid>>6; float*fl=(float*)(lds+LDS_FL); float*ws=(float*)(lds+LDS_WS);
  float v[8]; float run=0.f; int toff=tid*8; asm volatile("":"+v"(toff));
  #pragma unroll
  for(int j=0;j<8;++j){ run+=logf_bh[toff+j]; v[j]=run; }
  float inc=run;
  #pragma unroll
  for(int o=1;o<64;o<<=1){ const float x=__shfl_up(inc,o); if(lane>=o)inc+=x; }
  if(lane==63)ws[wid]=inc;
  __syncthreads();
  float base=inc-run;
  for(int w=0;w<wid;++w)base+=ws[w];
  u32x2_t*kx=(u32x2_t*)(lds+LDS_KX);
  #pragma unroll
  for(int j=0;j<8;++j){ const float f=-(base+v[j])*1.4426950408889634f; fl[tid*8+j]=f; unsigned h0,h1,h2; split3(f,h0,h1,h2); kx[tid*8+j]=(u32x2_t){h0|(h1<<16),h2|0x3f800000u}; }
  __syncthreads();
}
template<class Sched,int THRL=8> __device__ __forceinline__ void attn_phase(char*lds,const AttnTensors&T,const Sched&S,const float*qg,const float*kg){
  float gq=fabsf(qg[threadIdx.x&63]),gk=fabsf(kg[threadIdx.x&63]);
  #pragma unroll
  for(int o=1;o<64;o<<=1){gq=fmaxf(gq,__shfl_xor(gq,o));gk=fmaxf(gk,__shfl_xor(gk,o));}
  const float qbound=64.f*C2*gq*gk*1.01f+0.01f, skip_thr=2.f*qbound+40.f;
  AttnUnit u; int cur_bh=-1;
  for(int i=0;S.next(i,u);++i){
    if(u.bh!=cur_bh){ build_forget_table(lds,T.logf+(size_t)u.bh*SEQ); cur_bh=u.bh; }
    attn_unit<THRL>(u.bh/NHEAD,u.bh%NHEAD,u.qb,T.Q,T.K,T.V,T.O,T.G,lds,qbound,skip_thr); }
}
#undef SBAR
#undef WAIT_BAR
}
namespace mk {
#define LAS __attribute__((address_space(3)))
#define GAS __attribute__((address_space(1)))
typedef unsigned short bf16_t;
typedef short bf16x8 __attribute__((ext_vector_type(8)));
typedef float f32x4 __attribute__((ext_vector_type(4)));
typedef float f32x2 __attribute__((ext_vector_type(2)));
typedef unsigned u32x4 __attribute__((ext_vector_type(4)));
typedef unsigned u32x2 __attribute__((ext_vector_type(2)));
constexpr int NWAVES = 8, NTHR = 512;
constexpr int D = 1024, NB = 8, L = 4096, T = NB * L, G = 64, P = 64, GC = 16, H = 16, HD = 64, NE = 32, FH = 256;
constexpr float EPS = 1e-6f;
constexpr float C2Q = 0.125f * 1.4426950408889634f;

constexpr size_t MiB = 1u << 20;
constexpr size_t WS_CTL = 0, CTL_ZERO_BYTES = 1 * MiB;
constexpr size_t WS_MODS = 1 * MiB;
constexpr size_t WS_LOGF = 2 * MiB;
constexpr size_t WS_EW = 4 * MiB;
constexpr size_t WS_EID = 4 * MiB + 512 * 1024;
constexpr size_t WS_LIST = 5 * MiB;
constexpr size_t WS_A64 = 9 * MiB;
constexpr size_t WS_BT_IN = 10 * MiB, WS_BT_OUT = 12 * MiB, WS_BT_KV = 16 * MiB, WS_BT_FZ = 20 * MiB, WS_BT_R = 20 * MiB + 512 * 1024;
constexpr size_t WS_BT_QG = 22 * MiB, WS_BT_O = 26 * MiB, WS_BT1 = 28 * MiB, WS_BT2 = 92 * MiB;
constexpr size_t WS_SLOT0 = 124 * MiB, SLOT = 64 * MiB;
constexpr size_t WS_END = WS_SLOT0 + 6 * SLOT;
#define SLOTP(i) (WS_SLOT0 + (size_t)(i) * SLOT)
constexpr size_t WS_KTAB = SLOTP(5), WS_WB = SLOTP(5) + 8 * MiB, WS_VT = SLOTP(5) + 24 * MiB;
constexpr int KTAB_G = 127 * 256;
constexpr int CW_TMO = 0, CW_CNT = 64  , CW_BAR = 4096;

constexpr int RING_BYTES = 131072, LDS_IDX_OFF = RING_BYTES  , LDSCTL_OFF = RING_BYTES + 2048, MISC_OFF = LDSCTL_OFF + 320;
constexpr int LDS_BYTES = 147456;

__device__ __forceinline__ unsigned f2bf(float f) { unsigned u = __builtin_bit_cast(unsigned, f); return (u + 0x7fffu + ((u >> 16) & 1u)) >> 16; }
__device__ __forceinline__ unsigned pk2(float lo, float hi) { typedef float v2f __attribute__((ext_vector_type(2))); typedef __bf16 v2b __attribute__((ext_vector_type(2))); v2f v = {lo, hi}; v2b b = __builtin_convertvector(v, v2b); return __builtin_bit_cast(unsigned, b); }
__device__ __forceinline__ float bflo(unsigned w) { return __builtin_bit_cast(float, w << 16); }
__device__ __forceinline__ float bfhi(unsigned w) { return __builtin_bit_cast(float, w & 0xffff0000u); }
__device__ __forceinline__ float fast_sigmoid(float x) { return __builtin_amdgcn_rcpf(1.0f + __builtin_amdgcn_exp2f(-1.4426950408889634f * x)); }
__device__ __forceinline__ float fast_silu(float x) { return x * fast_sigmoid(x); }
__device__ __forceinline__ float fast_gelu_tanh(float x) { const float z = 0.7978845608028654f * (x + 0.044715f * x * x * x); return x * fast_sigmoid(2.0f * z); }
__device__ __forceinline__ float wave_sum(float v) {
#pragma unroll
    for (int o = 1; o < 64; o <<= 1) v += __shfl_xor(v, o);
    return v;
}
#define LDS_WAIT() asm volatile("s_waitcnt lgkmcnt(0)" ::: "memory")
#define VM_WAIT() asm volatile("s_waitcnt vmcnt(0)" ::: "memory")

#define XB_TMO      128
#define XB_XCNT(j)  (256  + 64 * (j))
#define XB_XSUB(j)  (1280 + 64 * (j))
#define XB_XGEN(j)  (2304 + 64 * (j))
#define XB_TOP      3328
#define XB_TOPGEN   3392
#define XCD_BAR_WORDS 3456
#define XB_SPIN_CAP (1u << 18)
__device__ __forceinline__ unsigned xb_ld(unsigned* p)              { return __hip_atomic_load(p, __ATOMIC_RELAXED, __HIP_MEMORY_SCOPE_AGENT); }
__device__ __forceinline__ unsigned xb_add(unsigned* p, unsigned v) { return __hip_atomic_fetch_add(p, v, __ATOMIC_RELAXED, __HIP_MEMORY_SCOPE_AGENT); }
__device__ __forceinline__ unsigned xb_xcc_id() { return (unsigned)__builtin_amdgcn_s_getreg((3 << 11) | 20) & 0xFu; }
#define XB_SPIN(cond, bar) do { unsigned _sp = 0; while (cond) { __builtin_amdgcn_s_sleep(1); \
    if ((++_sp & 255u) == 0u) { if (xb_ld(&(bar)[XB_TMO])) break; if (_sp > XB_SPIN_CAP) { atomicAdd(&(bar)[XB_TMO], 1u); break; } } } } while (0)
struct XcdBarrier { unsigned* bar; unsigned x; volatile LAS unsigned* st; };
__device__ __forceinline__ XcdBarrier xcd_barrier_post(unsigned* bar, volatile LAS unsigned* st) {
    XcdBarrier b; b.bar = bar; b.x = xb_xcc_id(); b.st = st;
    if (threadIdx.x == 0) (void)xb_add(&bar[XB_XCNT(b.x)], 1u);
    return b;
}
__device__ __forceinline__ void xcd_barrier_complete(unsigned* bar, unsigned x, unsigned& nloc, unsigned& nx) {
    const unsigned Gd = gridDim.x * gridDim.y * gridDim.z;
    unsigned sum, cnt, mine, sp = 0u;
    for (;;) {
        sum = 0u; cnt = 0u; mine = 0u;
#pragma unroll
        for (unsigned j = 0; j < 16; ++j) { const unsigned c = xb_ld(&bar[XB_XCNT(j)]); sum += c; cnt += (c > 0u) ? 1u : 0u; mine = (j == x) ? c : mine; }
        if (sum == Gd) break;
        __builtin_amdgcn_s_sleep(1);
        if ((++sp & 255u) == 0u) { if (xb_ld(&bar[XB_TMO])) break; if (sp > XB_SPIN_CAP) { atomicAdd(&bar[XB_TMO], 1u); break; } }
    }
    nloc = mine > 0u ? mine : 1u; nx = cnt > 0u ? cnt : 1u;
}
__device__ __forceinline__ void xcd_barrier(const XcdBarrier& b) {
    asm volatile("s_waitcnt vmcnt(0)" ::: "memory");
    __syncthreads();
    if (threadIdx.x == 0) {
        unsigned* bar = b.bar;
        __builtin_amdgcn_s_waitcnt(0);
        unsigned nloc = b.st[0], nx = b.st[1];
        if (nloc == 0u) { xcd_barrier_complete(bar, b.x, nloc, nx); b.st[0] = nloc; b.st[1] = nx; }
        const unsigned old = xb_add(&bar[XB_XSUB(b.x)], 1u);
        const unsigned gen = old / nloc;
        if (old + 1u == (gen + 1u) * nloc) {
            __builtin_amdgcn_fence(__ATOMIC_RELEASE, "agent");
            asm volatile("s_waitcnt vmcnt(0)" ::: "memory");
            const unsigned og = xb_add(&bar[XB_TOP], 1u);
            const unsigned tg = og / nx;
            if (og + 1u == (tg + 1u) * nx) xb_add(&bar[XB_TOPGEN], 1u);
            else XB_SPIN(xb_ld(&bar[XB_TOPGEN]) == tg, bar);
            __builtin_amdgcn_fence(__ATOMIC_ACQUIRE, "agent");
            xb_add(&bar[XB_XGEN(b.x)], 1u);
            asm volatile("s_waitcnt vmcnt(0)" ::: "memory");
        } else {
            XB_SPIN(xb_ld(&bar[XB_XGEN(b.x)]) == gen, bar);
            __builtin_amdgcn_fence(__ATOMIC_ACQUIRE, "agent");
            asm volatile("s_waitcnt vmcnt(0)" ::: "memory");
        }
    }
    __syncthreads();
}

struct Args { const float* in[31]; float* out; unsigned char* ws; int ph_lo, ph_hi; };
struct Frame {
    LAS unsigned char* lds; unsigned char* ws; const float* const* in; float* out;
    int tid, lane, wave, vcu, G;
};
enum In { I_X = 0, I_C, I_LNG, I_ADAW, I_ADAB, I_WIN, I_LRE, I_LIM, I_LOGDT, I_BRE, I_BIM, I_CRE, I_CIM, I_DSK, I_WOUT, I_KVG, I_KVADAW, I_KVADAB, I_KVW, I_KVFB, I_KNG,
          I_WQG, I_QNG, I_WO, I_MWG, I_MBG, I_MWE, I_MBE, I_MW1, I_MW3, I_MW2 };

namespace pg {
constexpr int BM = 256, BK = 64, HALF = 128, HTB = HALF * BK * 2, STAGE_BYTES = 8 * HTB, NXCD = 8, WGM = 8;
__host__ __device__ __forceinline__ int lds_byte(int r, int c) { const int st = (r >> 4) * 2 + (c >> 5), rr = r & 15, cc = c & 31, ob = rr * 64 + cc * 2; return st * 1024 + (ob ^ (((ob >> 9) & 1) << 5)); }
__host__ __device__ __forceinline__ void stage_rc(int b, int& R, int& C) { const int st = b / 1024, sb = b % 1024, swz = sb ^ (((sb >> 9) & 1) << 5); R = (st >> 1) * 16 + swz / 64; C = (st & 1) * 32 + (swz % 64) / 2; }
__host__ __device__ __forceinline__ int perm32(int rho) { const int n = rho >> 4, i = rho & 15; return 8 * (i >> 2) + 4 * n + (i & 3); }

struct GUnit {
    const char* a0; const char* a1; const char* b0; const char* b1; int nt;
    const char* xa0; const char* xa1; const char* xb0; const char* xb1; int nt2;
    const int* rows; int nrows;
    int i0, i1, i2, i3;
};
struct KStep { long a, b, a2, b2; };
struct DenseOrder {
    int nM, nN, nwg, Gd, c;
    __device__ void init(int M, int N, int G_, int c_) { nM = M / BM; nN = N / BM; nwg = nM * nN; Gd = G_; c = c_; }
    __device__ bool next(int i, int& pm, int& pn) const {
        const long Li = (long)i * Gd + c; if (Li >= nwg) return false;
        int wgid = (int)Li; { const int q = nwg / NXCD, r = nwg % NXCD, xcd = wgid % NXCD, off = wgid / NXCD; wgid = (xcd < r ? xcd * (q + 1) : r * (q + 1) + (xcd - r) * q) + off; }
        const int nig = WGM * nN, gid = wgid / nig, fm = gid * WGM, gsz = (nM - fm) < WGM ? (nM - fm) : WGM;
        pm = fm + ((wgid % nig) % gsz); pn = (wgid % nig) / gsz; return true;
    }
};
__device__ __forceinline__ unsigned cvt_pk_bf16(float lo, float hi) { unsigned r; asm volatile("v_cvt_pk_bf16_f32 %0, %1, %2" : "=v"(r) : "v"(lo), "v"(hi)); return r; }

struct LaneOff { int a[2], b[2], a2[2], b2[2]; };
template <class Epi, class Sched, bool SEG2, bool GATHER, bool ALIGN_EPI>
__device__ __forceinline__ void gemm_phase(LAS unsigned char* lds, const Sched& S, const Epi& E, const KStep ks, const LaneOff lo, const int gpitch) {
    int tid = threadIdx.x; asm volatile("" : "+v"(tid));
    const int wid = __builtin_amdgcn_readfirstlane(tid >> 6), lane = tid & 63, wr = wid >> 2, wc = wid & 3, fr = lane & 15, fq = lane >> 4;
    const unsigned ldsw = (unsigned)wid * 1024u;
    const int aoff = lds_byte(wr * 64 + fr, fq * 8), boff = lds_byte(wc * 32 + fr, fq * 8);
#define PG_SA(b, h) (((b) * 2 + (h)) * HTB)
#define PG_SB(b, h) ((4 + (b) * 2 + (h)) * HTB)
#define PG_STAGE(bufoff, gbase, v0, v1) do { \
        __builtin_amdgcn_global_load_lds((const unsigned*)((const char*)(gbase) + (long)(v0)), (LAS unsigned*)(lds + (bufoff) + ldsw), 16, 0, 0); \
        __builtin_amdgcn_global_load_lds((const unsigned*)((const char*)(gbase) + (long)(v1)), (LAS unsigned*)(lds + (bufoff) + ldsw + 8192), 16, 0, 0); } while (0)
#define PG_LDA(dst, b, h) do { _Pragma("unroll") for (int m = 0; m < 4; ++m) _Pragma("unroll") for (int k = 0; k < 2; ++k) dst[m][k] = *(const LAS bf16x8*)(lds + PG_SA(b, h) + aoff + m * 2048 + k * 1024); } while (0)
#define PG_LDB(dst, b, h) do { _Pragma("unroll") for (int n = 0; n < 2; ++n) _Pragma("unroll") for (int k = 0; k < 2; ++k) dst[n][k] = *(const LAS bf16x8*)(lds + PG_SB(b, h) + boff + n * 2048 + k * 1024); } while (0)
#define PG_MMA(ai, bj, At, Bt) do { __builtin_amdgcn_s_setprio(1); _Pragma("unroll") for (int m = 0; m < 4; ++m) _Pragma("unroll") for (int n = 0; n < 2; ++n) _Pragma("unroll") for (int k = 0; k < 2; ++k) \
        acc[ai][bj][m][n] = __builtin_amdgcn_mfma_f32_16x16x32_bf16(Bt[n][k], At[m][k], acc[ai][bj][m][n], 0, 0, 0); __builtin_amdgcn_s_setprio(0); } while (0)
#define PG_WAIT_V(n) asm volatile("s_waitcnt vmcnt(" #n ")" ::: "memory")
#define PG_WAIT_L(n) asm volatile("s_waitcnt lgkmcnt(" #n ")" ::: "memory")
#define PG_BAR __builtin_amdgcn_s_barrier()
#define PG_SCHED __builtin_amdgcn_sched_barrier(0)
#define PG_TILE(u, tau, A0, A1, B0, B1, S2) do { const int _t = (tau); \
        if (SEG2 && _t >= (u).nt) { const long _o = (long)(_t - (u).nt); A0 = (u).xa0 + _o * ks.a2; A1 = (u).xa1 + _o * ks.a2; B0 = (u).xb0 + _o * ks.b2; B1 = (u).xb1 + _o * ks.b2; S2 = true; } \
        else { const long _o = (long)_t; A0 = (u).a0 + _o * ks.a; A1 = (u).a1 + _o * ks.a; B0 = (u).b0 + _o * ks.b; B1 = (u).b1 + _o * ks.b; S2 = false; } } while (0)
    LAS int* idxl = (LAS int*)(lds + LDS_IDX_OFF + wid * 256);
#define PG_FETCH_IDX(u) do { const int _g = lane >> 4; const int _row = (_g >> 1) * 128 + ((wid >> 1) + 4 * (_g & 1)) * 16 + (lane & 15); \
        __builtin_amdgcn_global_load_lds((const unsigned*)((u).rows + _row), (LAS unsigned*)idxl, 4, 0, 0); } while (0)
#define PG_READ_IDX(u, V) do { _Pragma("unroll") for (int _h = 0; _h < 2; ++_h) _Pragma("unroll") for (int _i = 0; _i < 2; ++_i) { \
        const int _rp = _h * 128 + ((wid >> 1) + 4 * _i) * 16 + (lane >> 2); const int _e = idxl[(_h * 2 + _i) * 16 + (lane >> 2)]; \
        const int _tok = (_rp < (u).nrows) ? ((_e & 0xffff) >> 1) : 0; V[_h][_i] = _tok * gpitch + lo.a[_i]; } } while (0)
    GUnit cur, nxt; int ui = 0;
    if (!S.next(0, cur)) return;
    f32x4 acc[2][2][4][2];
#pragma unroll
    for (int a = 0; a < 2; ++a)
#pragma unroll
        for (int b = 0; b < 2; ++b)
#pragma unroll
            for (int m = 0; m < 4; ++m)
#pragma unroll
                for (int n = 0; n < 2; ++n) acc[a][b][m][n] = (f32x4){0.f, 0.f, 0.f, 0.f};
    bf16x8 At[4][2], B0[2][2], B1[2][2];
    int vA[2][2], vAn[2][2];
    if constexpr (GATHER) { PG_FETCH_IDX(cur); PG_WAIT_V(0); PG_READ_IDX(cur, vA); }
    else { vA[0][0] = vA[1][0] = lo.a[0]; vA[0][1] = vA[1][1] = lo.a[1]; }
#pragma unroll
    for (int h = 0; h < 2; ++h)
#pragma unroll
        for (int i = 0; i < 2; ++i) vAn[h][i] = vA[h][i];
    {
        const char *pa0, *pa1, *pb0, *pb1; bool s2;
        PG_TILE(cur, 0, pa0, pa1, pb0, pb1, s2);
        PG_STAGE(PG_SB(0, 0), pb0, lo.b[0], lo.b[1]); PG_STAGE(PG_SB(0, 1), pb1, lo.b[0], lo.b[1]); PG_STAGE(PG_SA(0, 0), pa0, vA[0][0], vA[0][1]); PG_STAGE(PG_SA(0, 1), pa1, vA[1][0], vA[1][1]);
        if (wr == 1) PG_BAR;
        PG_WAIT_V(2); PG_BAR;
        PG_TILE(cur, 1, pa0, pa1, pb0, pb1, s2);
        PG_STAGE(PG_SB(1, 0), pb0, lo.b[0], lo.b[1]); PG_STAGE(PG_SA(1, 0), pa0, vA[0][0], vA[0][1]); PG_STAGE(PG_SB(1, 1), pb1, lo.b[0], lo.b[1]);
        PG_WAIT_V(6); PG_BAR;
    }
    for (;;) {
        const bool has_next = S.next(ui + 1, nxt);
        const int ntt = cur.nt + (SEG2 ? cur.nt2 : 0);
#pragma clang loop unroll(disable)
        for (int t = 0; t < ntt; t += 2) {
            const bool last = (t == ntt - 2);
            if constexpr (GATHER) { if (has_next && t == ntt - 4) PG_FETCH_IDX(nxt); if (has_next && last) PG_READ_IDX(nxt, vAn); }
            const char *q0, *q1a1, *q2, *q3; bool s1; PG_TILE(cur, t + 1, q0, q1a1, q2, q3, s1); (void)q0; (void)q2; (void)q3;
            const char *a20, *a21, *b20, *b21, *a30, *a31, *b30, *b31; bool s2, s3;
            if (last) { if (has_next) { PG_TILE(nxt, 0, a20, a21, b20, b21, s2); PG_TILE(nxt, 1, a30, a31, b30, b31, s3); } else { PG_TILE(cur, 0, a20, a21, b20, b21, s2); PG_TILE(cur, 1, a30, a31, b30, b31, s3); } }
            else { PG_TILE(cur, t + 2, a20, a21, b20, b21, s2); PG_TILE(cur, t + 3, a30, a31, b30, b31, s3); }
            (void)a31;
            const bool nx2 = last && has_next;
            int o1a[2], o2a[2][2], o2b[2], o3a[2], o3b[2];
#pragma unroll
            for (int i = 0; i < 2; ++i) {
                o1a[i] = (SEG2 && s1) ? lo.a2[i] : vA[1][i];
                o2a[0][i] = (SEG2 && s2) ? lo.a2[i] : (nx2 ? vAn[0][i] : vA[0][i]); o2a[1][i] = (SEG2 && s2) ? lo.a2[i] : (nx2 ? vAn[1][i] : vA[1][i]);
                o2b[i] = (SEG2 && s2) ? lo.b2[i] : lo.b[i];
                o3a[i] = (SEG2 && s3) ? lo.a2[i] : (nx2 ? vAn[0][i] : vA[0][i]); o3b[i] = (SEG2 && s3) ? lo.b2[i] : lo.b[i];
            }
            PG_LDB(B0, 0, 0); PG_LDB(B1, 0, 1); PG_SCHED; PG_LDA(At, 0, 0); PG_STAGE(PG_SA(1, 1), q1a1, o1a[0], o1a[1]);
            PG_WAIT_V(8); PG_WAIT_L(0); PG_BAR; PG_MMA(0, 0, At, B0); PG_MMA(0, 1, At, B1); PG_BAR; PG_SCHED;
            PG_LDA(At, 0, 1); PG_STAGE(PG_SB(0, 0), b20, o2b[0], o2b[1]); PG_STAGE(PG_SB(0, 1), b21, o2b[0], o2b[1]); PG_STAGE(PG_SA(0, 0), a20, o2a[0][0], o2a[0][1]);
            PG_WAIT_V(8); PG_WAIT_L(0); PG_BAR; PG_MMA(1, 0, At, B0); PG_MMA(1, 1, At, B1); PG_BAR; PG_SCHED;
            PG_LDB(B0, 1, 0); PG_LDB(B1, 1, 1); PG_SCHED; PG_LDA(At, 1, 0); PG_STAGE(PG_SA(0, 1), a21, o2a[1][0], o2a[1][1]);
            PG_WAIT_V(8); PG_WAIT_L(0); PG_BAR; PG_MMA(0, 0, At, B0); PG_MMA(0, 1, At, B1); PG_BAR; PG_SCHED;
            PG_LDA(At, 1, 1); PG_STAGE(PG_SB(1, 0), b30, o3b[0], o3b[1]); PG_STAGE(PG_SB(1, 1), b31, o3b[0], o3b[1]); PG_STAGE(PG_SA(1, 0), a30, o3a[0], o3a[1]);
            PG_WAIT_V(8); PG_WAIT_L(0); PG_BAR; PG_MMA(1, 0, At, B0); PG_MMA(1, 1, At, B1); PG_BAR; PG_SCHED;
        }
        if constexpr (ALIGN_EPI) { if (wr == 0) PG_BAR; }
        if constexpr (!Epi::AFTER_DRAIN) { E(acc, cur, wr, wc, fr, fq); }
        if (!has_next) break;
#pragma unroll
        for (int a = 0; a < 2; ++a)
#pragma unroll
            for (int b = 0; b < 2; ++b)
#pragma unroll
                for (int m = 0; m < 4; ++m)
#pragma unroll
                    for (int n = 0; n < 2; ++n) acc[a][b][m][n] = (f32x4){0.f, 0.f, 0.f, 0.f};
        cur = nxt; ++ui;
#pragma unroll
        for (int h = 0; h < 2; ++h)
#pragma unroll
            for (int i = 0; i < 2; ++i) vA[h][i] = vAn[h][i];
        if constexpr (ALIGN_EPI) { if (wr == 1) PG_BAR; }
    }
    PG_WAIT_V(0);
    if constexpr (!ALIGN_EPI) { if (wr == 0) PG_BAR; }
    PG_BAR;
    if constexpr (Epi::AFTER_DRAIN) { E.fused(acc, cur, wr, wc, fr, fq, lds, wid, lane); }
#undef PG_SA
#undef PG_SB
#undef PG_STAGE
#undef PG_LDA
#undef PG_LDB
#undef PG_MMA
#undef PG_WAIT_V
#undef PG_WAIT_L
#undef PG_BAR
#undef PG_SCHED
#undef PG_TILE
#undef PG_FETCH_IDX
#undef PG_READ_IDX
}
__device__ __forceinline__ void lane_off_rowmajor(int (&v)[2], int pitch, bool perm) {
    int tid = threadIdx.x; asm volatile("" : "+v"(tid));
#pragma unroll
    for (int i = 0; i < 2; ++i) { int R, C; stage_rc(tid * 16 + i * 8192, R, C); const int Rb = perm ? ((R & ~31) + perm32(R & 31)) : R; v[i] = Rb * pitch + C * 2; }
}
}
__device__ __forceinline__ void p0_mods(Frame& F) {
    LAS float* sc = (LAS float*)F.lds;
    LAS float* red = (LAS float*)(F.lds + 32768);
    const float* c = F.in[I_C];
    for (int i = F.tid; i < NB * D; i += NTHR) { const float v = c[i]; sc[i] = v / (1.0f + __expf(-v)); }
    __syncthreads();
    float* mods = (float*)(F.ws + WS_MODS);
    const int seg = F.tid >> 6, col = F.tid & 63;
    for (int item = F.vcu; item < 224; item += F.G) {
        int set, c0, N; const float* W; const float* bias;
        if (item < 192) { set = item / 48; c0 = (item % 48) * 64; N = 3072; W = F.in[I_ADAW] + (size_t)set * D * 3072; bias = F.in[I_ADAB] + set * 3072; }
        else { set = 4; c0 = (item - 192) * 64; N = 2048; W = F.in[I_KVADAW]; bias = F.in[I_KVADAB]; }
        float acc[NB];
#pragma unroll
        for (int b = 0; b < NB; ++b) acc[b] = 0.f;
        const float* wp = W + (size_t)(seg * 128) * N + c0 + col;
#pragma unroll 1
        for (int d0 = 0; d0 < 128; d0 += 32) { float wv[32];
#pragma unroll
            for (int d = 0; d < 32; ++d) wv[d] = wp[(size_t)(d0 + d) * N];
#pragma unroll
            for (int d = 0; d < 32; ++d)
#pragma unroll
                for (int b = 0; b < NB; ++b) acc[b] += sc[b * D + seg * 128 + d0 + d] * wv[d]; }
#pragma unroll
        for (int b = 0; b < NB; ++b) red[(seg * NB + b) * 64 + col] = acc[b];
        __syncthreads();
        { const int b = F.tid >> 6; float s = 0.f;
#pragma unroll
            for (int sg = 0; sg < 8; ++sg) s += red[(sg * NB + b) * 64 + col];
            mods[(set * NB + b) * 3072 + c0 + col] = s + bias[c0 + col]; }
        __syncthreads();
    }
}
template <class Map>
__device__ __forceinline__ void p0_tr_item(const float* W, int ldw, int K, bf16_t* WT, LAS float* scr, int item, int nblk, int lane, Map map) {
    const int kb = item / nblk, nb = item % nblk, k0 = 64 * kb, n0 = 32 * nb;
    float tv[32];
#pragma unroll
    for (int i = 0; i < 32; ++i) { const int kk = 2 * i + (lane >> 5); tv[i] = W[(size_t)(k0 + kk) * ldw + n0 + (lane & 31)]; }
#pragma unroll
    for (int i = 0; i < 32; ++i) { const int kk = 2 * i + (lane >> 5); scr[kk * 33 + (lane & 31)] = tv[i]; }
    LDS_WAIT(); asm volatile("" ::: "memory");
    const int c = lane & 7;
#pragma unroll
    for (int j = 0; j < 4; ++j) { const int n = (lane >> 3) + 8 * j; const LAS float* s = scr + (8 * c) * 33 + n;
        u32x4 o; o.x = pk2(s[0 * 33], s[1 * 33]); o.y = pk2(s[2 * 33], s[3 * 33]); o.z = pk2(s[4 * 33], s[5 * 33]); o.w = pk2(s[6 * 33], s[7 * 33]);
        *(u32x4*)(WT + (size_t)map(n0 + n) * K + k0 + 8 * c) = o; }
    LDS_WAIT(); asm volatile("" ::: "memory");
}
struct MapId { __device__ int operator()(int n) const { return n; } };
struct MapGlu { __device__ int operator()(int c) const { const int bj = c >> 10, cc = c & 1023; return (cc >> 7) * 256 + bj * 128 + (cc & 127); } };
struct MapHead { __device__ int operator()(int c) const { const int part = c >> 10, head = (c & 1023) >> 6, d = c & 63;
        const int pn = part * 4 + (head >> 2), wc = head & 3, fq = d >> 4, bj = (d >> 3) & 1, n = (d >> 2) & 1, j = d & 3; return pn * 256 + 128 * bj + 32 * wc + 16 * n + 4 * fq + j; } };
struct MapUp { int bj; __device__ int operator()(int f) const { return (f >> 7) * 256 + bj * 128 + (f & 127); } };
__device__ __forceinline__ void p0_convert(Frame& F) {
    LAS float* scr = (LAS float*)(F.lds + F.wave * 16384);
    const int gw = F.vcu * NWAVES + F.wave, NGW = F.G * NWAVES;
    constexpr int I_IN = 16 * 32, I_OUT = 16 * 64, I_KV = 16 * 64, I_QG = 16 * 64, I_O = 16 * 32, I_UP = 16 * 8, I_DN = 4 * 32;
    constexpr int NITEMS = I_IN + I_OUT + I_KV + I_QG + I_O + 64 * (2 * I_UP + I_DN);
    unsigned char* ws = F.ws;
    for (int it = gw; it < NITEMS; it += NGW) {
        int r = it;
        if (r < I_IN) { p0_tr_item(F.in[I_WIN], 1024, 1024, (bf16_t*)(ws + WS_BT_IN), scr, r, 32, F.lane, MapId()); continue; } r -= I_IN;
        if (r < I_OUT) { p0_tr_item(F.in[I_WOUT], 2048, 1024, (bf16_t*)(ws + WS_BT_OUT), scr, r, 64, F.lane, MapGlu()); continue; } r -= I_OUT;
        if (r < I_KV) { p0_tr_item(F.in[I_KVW], 2064, 1024, (bf16_t*)(ws + WS_BT_KV), scr, r, 64, F.lane, MapHead()); continue; } r -= I_KV;
        if (r < I_QG) { p0_tr_item(F.in[I_WQG], 2048, 1024, (bf16_t*)(ws + WS_BT_QG), scr, r, 64, F.lane, MapHead()); continue; } r -= I_QG;
        if (r < I_O) { p0_tr_item(F.in[I_WO], 1024, 1024, (bf16_t*)(ws + WS_BT_O), scr, r, 32, F.lane, MapId()); continue; } r -= I_O;
        const int le = r / (2 * I_UP + I_DN), q = r % (2 * I_UP + I_DN);
        if (q < I_UP) { MapUp m{0}; p0_tr_item(F.in[I_MW1] + (size_t)le * D * FH, 256, 1024, (bf16_t*)(ws + WS_BT1) + (size_t)le * 512 * 1024, scr, q, 8, F.lane, m); }
        else if (q < 2 * I_UP) { MapUp m{1}; p0_tr_item(F.in[I_MW3] + (size_t)le * D * FH, 256, 1024, (bf16_t*)(ws + WS_BT1) + (size_t)le * 512 * 1024, scr, q - I_UP, 8, F.lane, m); }
        else p0_tr_item(F.in[I_MW2] + (size_t)le * FH * D, 1024, 256, (bf16_t*)(ws + WS_BT2) + (size_t)le * 1024 * 256, scr, q - 2 * I_UP, 32, F.lane, MapId());
    }
    const int gt = F.vcu * NTHR + F.tid, NGT = F.G * NTHR;
    for (int it = gt; it < 3 * 256 * 128; it += NGT) {
        const int m = it / (256 * 128), row = (it / 128) % 256, k0 = (it % 128) * 8;
        float v[8];
#pragma unroll
        for (int j = 0; j < 8; ++j) v[j] = 0.f;
        bf16_t* dst;
        if (m == 0) { dst = (bf16_t*)(ws + WS_BT_FZ);
            if (row < 16) {
#pragma unroll
                for (int j = 0; j < 8; ++j) v[j] = F.in[I_KVW][(size_t)(k0 + j) * 2064 + 2048 + row]; } }
        else { const int l = m - 1; dst = (bf16_t*)(ws + WS_BT_R) + (size_t)l * 256 * 1024;
            if (row < 32) { const int grp = (row & 15) >> 2, e = grp * 8 + (row >> 4) * 4 + (row & 3);
#pragma unroll
                for (int j = 0; j < 8; ++j) v[j] = F.in[I_MWE][(size_t)l * D * 32 + (size_t)(k0 + j) * 32 + e]; }
            else if (row >= 128 && row < 144 && (row & 3) == 0) { const int grp = (row - 128) >> 2;
#pragma unroll
                for (int j = 0; j < 8; ++j) v[j] = F.in[I_MWG][(size_t)l * D * 4 + (size_t)(k0 + j) * 4 + grp]; } }
        u32x4 o; o.x = pk2(v[0], v[1]); o.y = pk2(v[2], v[3]); o.z = pk2(v[4], v[5]); o.w = pk2(v[6], v[7]);
        *(u32x4*)(dst + (size_t)row * 1024 + k0) = o;
    }
}
__device__ __forceinline__ void p0_s5_tables(Frame& F) {
    LAS double* lam = (LAS double*)F.lds;
    LAS f32x2* bb = (LAS f32x2*)(F.lds + 1024);
    LAS f32x2* Cc = (LAS f32x2*)(F.lds + 1024 + 8192);
    LAS f32x2* pw = (LAS f32x2*)(F.lds + 1024 + 16384);
    unsigned char* ws = F.ws;
    for (int job = F.vcu; job < 256; job += F.G) {
        const int g = job >> 2, q = job & 3;
        __syncthreads();
        if (F.tid < 64) { const int p = F.tid;
            const double dt = exp((double)F.in[I_LOGDT][g]), lr = F.in[I_LRE][g * P + p], li = F.in[I_LIM][g * P + p];
            const double mag = exp(lr * dt), ar = mag * cos(li * dt), ai = mag * sin(li * dt), den = lr * lr + li * li;
            const double cr = ((ar - 1.0) * lr + ai * li) / den, ci = (ai * lr - (ar - 1.0) * li) / den;
            lam[2 * p] = lr * dt; lam[2 * p + 1] = li * dt;
            for (int c = 0; c < GC; ++c) { const double br = F.in[I_BRE][(g * P + p) * GC + c], bi = F.in[I_BIM][(g * P + p) * GC + c];
                bb[p * GC + c] = (f32x2){(float)(cr * br - ci * bi), (float)(cr * bi + ci * br)}; } }
        for (int i = F.tid; i < GC * P; i += NTHR) Cc[i] = (f32x2){F.in[I_CRE][g * GC * P + i], F.in[I_CIM][g * GC * P + i]};
        __syncthreads();
        for (int i = F.tid; i < 65 * 64; i += NTHR) { const int lag = i >> 6, p = i & 63; const double m = exp(lam[2 * p] * lag), ph = lam[2 * p + 1] * lag; pw[i] = (f32x2){(float)(m * cos(ph)), (float)(m * sin(ph))}; }
        __syncthreads();
        if (q == 0 && F.tid < 64) ((f32x2*)(ws + WS_A64))[g * P + F.tid] = pw[64 * 64 + F.tid];
        bf16_t* kt = (bf16_t*)(ws + WS_KTAB) + (size_t)g * KTAB_G;
        for (int i = F.tid; i < 16 * 256; i += NTHR) { const int lag = 16 * q + (i >> 8), c = (i >> 4) & 15, c2 = i & 15; float s = 0.f;
            for (int p = 0; p < P; ++p) { const f32x2 cv = Cc[c * P + p], a = pw[lag * 64 + p], b = bb[p * GC + c2];
                const float tr = cv.x * a.x - cv.y * a.y, ti = cv.x * a.y + cv.y * a.x; s += tr * b.x - ti * b.y; }
            kt[(lag + 63) * 256 + c * 16 + c2] = (bf16_t)f2bf(s);
            if (lag < 63) kt[lag * 256 + c * 16 + c2] = 0; }
        bf16_t* wb = (bf16_t*)(ws + WS_WB) + (size_t)g * 128 * 1024;
        for (int i = F.tid; i < 64 * 256; i += NTHR) { const int p = i >> 8, jl = (i >> 4) & 15, c2 = i & 15, j = 16 * q + jl; const f32x2 a = pw[(63 - j) * 64 + p], b = bb[p * GC + c2];
            wb[(size_t)p * 1024 + j * 16 + c2] = (bf16_t)f2bf(a.x * b.x - a.y * b.y); wb[(size_t)(64 + p) * 1024 + j * 16 + c2] = (bf16_t)f2bf(a.x * b.y + a.y * b.x); }
        bf16_t* vt = (bf16_t*)(ws + WS_VT) + (size_t)g * 1024 * 128;
        for (int i = F.tid; i < 256 * 64; i += NTHR) { const int tc = i >> 6, p = i & 63, t = 16 * q + (tc >> 4), c = tc & 15; const f32x2 cv = Cc[c * P + p], a = pw[(t + 1) * 64 + p];
            vt[(size_t)(t * 16 + c) * 128 + p] = (bf16_t)f2bf(cv.x * a.x - cv.y * a.y); vt[(size_t)(t * 16 + c) * 128 + 64 + p] = (bf16_t)f2bf(-(cv.x * a.y + cv.y * a.x)); }
    }
    __syncthreads();
}

template <bool SRC_F32>
__device__ __forceinline__ void rows_norm_mod(Frame& F, const void* src, const float* g, const float* mod  , bf16_t* dst) {
    const int rows_per_blk = T / F.G;
    for (int r0 = F.vcu * rows_per_blk; r0 < T; r0 += F.G * rows_per_blk) {
        const int b = r0 / L;
        float gs[16], sh[16];
#pragma unroll
        for (int hlf = 0; hlf < 2; ++hlf)
#pragma unroll
            for (int j = 0; j < 8; ++j) { const int d = hlf * 512 + F.lane * 8 + j; gs[hlf * 8 + j] = g[d] * (1.0f + mod[b * 3072 + 1024 + d]); sh[hlf * 8 + j] = mod[b * 3072 + d]; }
        for (int row = r0 + F.wave; row < r0 + rows_per_blk; row += NWAVES) {
            float v[16];
            if constexpr (SRC_F32) { const float* s = (const float*)src + (size_t)row * D;
#pragma unroll
                for (int hlf = 0; hlf < 2; ++hlf) { const f32x4 x0 = *(const f32x4*)(s + hlf * 512 + F.lane * 8), x1 = *(const f32x4*)(s + hlf * 512 + F.lane * 8 + 4);
                    v[hlf * 8 + 0] = x0.x; v[hlf * 8 + 1] = x0.y; v[hlf * 8 + 2] = x0.z; v[hlf * 8 + 3] = x0.w; v[hlf * 8 + 4] = x1.x; v[hlf * 8 + 5] = x1.y; v[hlf * 8 + 6] = x1.z; v[hlf * 8 + 7] = x1.w; } }
            else { const bf16_t* s = (const bf16_t*)src + (size_t)row * D;
#pragma unroll
                for (int hlf = 0; hlf < 2; ++hlf) { const u32x4 x = *(const u32x4*)(s + hlf * 512 + F.lane * 8);
                    v[hlf * 8 + 0] = bflo(x.x); v[hlf * 8 + 1] = bfhi(x.x); v[hlf * 8 + 2] = bflo(x.y); v[hlf * 8 + 3] = bfhi(x.y); v[hlf * 8 + 4] = bflo(x.z); v[hlf * 8 + 5] = bfhi(x.z); v[hlf * 8 + 6] = bflo(x.w); v[hlf * 8 + 7] = bfhi(x.w); } }
            float ss = 0.f;
#pragma unroll
            for (int j = 0; j < 16; ++j) ss += v[j] * v[j];
            const float rstd = 1.0f / sqrtf(wave_sum(ss) * (1.0f / D) + EPS);
#pragma unroll
            for (int hlf = 0; hlf < 2; ++hlf) { u32x4 o; float y[8];
#pragma unroll
                for (int j = 0; j < 8; ++j) y[j] = v[hlf * 8 + j] * rstd * gs[hlf * 8 + j] + sh[hlf * 8 + j];
                o.x = pk2(y[0], y[1]); o.y = pk2(y[2], y[3]); o.z = pk2(y[4], y[5]); o.w = pk2(y[6], y[7]);
                *(u32x4*)(dst + (size_t)row * D + hlf * 512 + F.lane * 8) = o; }
        }
    }
}
struct SchedDense {
    pg::DenseOrder o; const char* A; const char* B; int apitch, bpitch, nt;
    __device__ bool next(int i, pg::GUnit& u) const { int pm, pn; if (!o.next(i, pm, pn)) return false;
        u.a0 = A + (size_t)pm * 256 * apitch; u.a1 = u.a0 + (size_t)128 * apitch; u.b0 = B + (size_t)pn * 256 * bpitch; u.b1 = u.b0 + (size_t)128 * bpitch; u.nt = nt; u.nt2 = 0; u.i0 = pm; u.i1 = pn; return true; }
};
struct EpiToGM { static constexpr bool PERM = true, AFTER_DRAIN = false; bf16_t* dst;
    __device__ __forceinline__ void operator()(const f32x4 (&acc)[2][2][4][2], const pg::GUnit& u, int wr, int wc, int fr, int fq) const {
        const int row0 = u.i0 * 256 + wr * 64 + fr, col0 = u.i1 * 256 + wc * 32 + 8 * fq;
#pragma unroll
        for (int ai = 0; ai < 2; ++ai)
#pragma unroll
            for (int m = 0; m < 4; ++m) { const int row = row0 + ai * 128 + m * 16;
#pragma unroll
                for (int bj = 0; bj < 2; ++bj) { const int c = col0 + bj * 128; const f32x4 v0 = acc[ai][bj][m][0], v1 = acc[ai][bj][m][1];
                    u32x4 w; w.x = pk2(v0[0], v0[1]); w.y = pk2(v0[2], v0[3]); w.z = pk2(v1[0], v1[1]); w.w = pk2(v1[2], v1[3]);
                    *(u32x4*)(dst + ((size_t)(c >> 4) * T + row) * 16 + (c & 15)) = w; } }
    }
};
struct SchedE { int c, Gd; const char* U; const char* Wb;
    __device__ bool next(int i, pg::GUnit& u) const { const int Li = i * Gd + c; if (i > 0 || Li >= 128) return false; const int g = Li >> 1, pm = Li & 1;
        u.a0 = U + (size_t)g * T * 32 + (size_t)pm * 256 * 2048; u.a1 = u.a0 + 128 * 2048; u.b0 = Wb + (size_t)g * 128 * 2048; u.b1 = u.b0; u.nt = 16; u.nt2 = 0; u.i0 = g; u.i1 = pm; return true; }
};
struct EpiScan { static constexpr bool PERM = false, AFTER_DRAIN = true; bf16_t* Sb; const f32x2* a64;
    __device__ __forceinline__ void fused(const f32x4 (&acc)[2][2][4][2], const pg::GUnit& u, int wr, int wc, int fr, int fq, LAS unsigned char* lds, int wid, int lane) const {
        LAS float* e = (LAS float*)lds;
#pragma unroll
        for (int ai = 0; ai < 2; ++ai)
#pragma unroll
            for (int m = 0; m < 4; ++m) { const int row = ai * 128 + wr * 64 + m * 16 + fr;
#pragma unroll
                for (int n = 0; n < 2; ++n) *(LAS f32x4*)(e + row * 128 + wc * 32 + n * 16 + 4 * fq) = acc[ai][0][m][n]; }
        LDS_WAIT(); __builtin_amdgcn_s_barrier(); asm volatile("" ::: "memory");
        const int tid = wid * 64 + lane;
        if (tid < 256) { const int bl = tid >> 6, p = tid & 63, g = u.i0; const f32x2 a = a64[g * P + p];
            bf16_t* out = Sb + ((size_t)g * 512 + (size_t)(u.i1 * 4 + bl) * 64) * 128;
            float sr = 0.f, si = 0.f;
            for (int k = 0; k < 64; ++k) { out[k * 128 + p] = (bf16_t)f2bf(sr); out[k * 128 + 64 + p] = (bf16_t)f2bf(si);
                const float er = e[(bl * 64 + k) * 128 + p], ei = e[(bl * 64 + k) * 128 + 64 + p];
                const float nr = a.x * sr - a.y * si + er, ni = a.x * si + a.y * sr + ei; sr = nr; si = ni; } }
    }
};
struct SchedY { int c, Gd; const char* U; const char* Sb; const char* Kt; const char* Vt;
    __device__ bool next(int i, pg::GUnit& u) const { const int Li = i * Gd + c; if (Li >= 512) return false; const int r = Li & 255, g = r >> 2, pm = (r >> 1) & 1, s = r & 1, pn = (Li < 256) ? s : 3 - s;
        u.a0 = U + (size_t)g * T * 32 + (size_t)pm * 256 * 2048; u.a1 = u.a0 + 128 * 2048;
        u.b0 = Kt + ((size_t)g * KTAB_G + (size_t)(16 * pn + 63) * 256) * 2; u.b1 = u.b0 + 8 * 512; u.nt = 4 * pn + 4;
        u.xa0 = Sb + ((size_t)g * 512 + pm * 256) * 256; u.xa1 = u.xa0 + 128 * 256; u.xb0 = Vt + ((size_t)g * 1024 + pn * 256) * 256; u.xb1 = u.xb0 + 128 * 256; u.nt2 = 2;
        u.i0 = g; u.i1 = pm; u.i2 = pn; return true; }
};
struct EpiY { static constexpr bool PERM = true, AFTER_DRAIN = false; const bf16_t* U; bf16_t* Y; const float* dsk;
    __device__ __forceinline__ void operator()(const f32x4 (&acc)[2][2][4][2], const pg::GUnit& u, int wr, int wc, int fr, int fq) const {
        const int g = u.i0, bk0 = u.i1 * 256 + wr * 64 + fr, c0 = wc * 32 + 8 * fq;
        const int cc = c0 & 15; float dk[8];
#pragma unroll
        for (int j = 0; j < 8; ++j) dk[j] = dsk[g * 16 + cc + j];
#pragma unroll
        for (int ai = 0; ai < 2; ++ai)
#pragma unroll
            for (int m = 0; m < 4; ++m) { const int bk = bk0 + ai * 128 + m * 16;
#pragma unroll
                for (int bj = 0; bj < 2; ++bj) { const int t = 16 * u.i2 + ((c0 + 128 * bj) >> 4); const size_t off = ((size_t)g * T + (size_t)bk * 64 + t) * 16 + cc;
                    const u32x4 uu = *(const u32x4*)(U + off); const f32x4 v0 = acc[ai][bj][m][0], v1 = acc[ai][bj][m][1];
                    float y[8] = {v0[0] + dk[0] * bflo(uu.x), v0[1] + dk[1] * bfhi(uu.x), v0[2] + dk[2] * bflo(uu.y), v0[3] + dk[3] * bfhi(uu.y),
                                  v1[0] + dk[4] * bflo(uu.z), v1[1] + dk[5] * bfhi(uu.z), v1[2] + dk[6] * bflo(uu.w), v1[3] + dk[7] * bfhi(uu.w)};
#pragma unroll
                    for (int j = 0; j < 8; ++j) y[j] = fast_gelu_tanh(y[j]);
                    u32x4 w; w.x = pk2(y[0], y[1]); w.y = pk2(y[2], y[3]); w.z = pk2(y[4], y[5]); w.w = pk2(y[6], y[7]);
                    *(u32x4*)(Y + off) = w; } }
    }
};
struct SchedOut { pg::DenseOrder o; const char* Y; const char* B;
    __device__ bool next(int i, pg::GUnit& u) const { int pm, pn; if (!o.next(i, pm, pn)) return false;
        u.a0 = Y + (size_t)pm * 256 * 32; u.a1 = u.a0 + 128 * 32; u.b0 = B + (size_t)pn * 256 * 2048; u.b1 = u.b0 + 128 * 2048; u.nt = 16; u.nt2 = 0; u.i0 = pm; u.i1 = pn; return true; }
};
struct EpiGluRes { static constexpr bool PERM = true, AFTER_DRAIN = false; const float* x; const float* mod  ; bf16_t* h1;
    __device__ __forceinline__ void operator()(const f32x4 (&acc)[2][2][4][2], const pg::GUnit& u, int wr, int wc, int fr, int fq) const {
        const int row0 = u.i0 * 256 + wr * 64 + fr, col = u.i1 * 128 + wc * 32 + 8 * fq, b = (u.i0 * 256) / L;
        float gt[8];
#pragma unroll
        for (int j = 0; j < 8; ++j) gt[j] = mod[b * 3072 + 2048 + col + j];
#pragma unroll
        for (int ai = 0; ai < 2; ++ai)
#pragma unroll
            for (int m = 0; m < 4; ++m) { const size_t off = (size_t)(row0 + ai * 128 + m * 16) * D + col;
                const f32x4 x0 = *(const f32x4*)(x + off), x1 = *(const f32x4*)(x + off + 4);
                const f32x4 a0 = acc[ai][0][m][0], a1 = acc[ai][0][m][1], g0 = acc[ai][1][m][0], g1 = acc[ai][1][m][1];
                float y[8];
#pragma unroll
                for (int j = 0; j < 4; ++j) { y[j] = x0[j] + gt[j] * a0[j] * fast_sigmoid(g0[j]); y[4 + j] = x1[j] + gt[4 + j] * a1[j] * fast_sigmoid(g1[j]); }
                u32x4 w; w.x = pk2(y[0], y[1]); w.y = pk2(y[2], y[3]); w.z = pk2(y[4], y[5]); w.w = pk2(y[6], y[7]);
                *(u32x4*)(h1 + off) = w; }
    }
};
constexpr int LIST_CAP = 32768;
struct EpiRoute { static constexpr bool PERM = false, AFTER_DRAIN = false; const float* bg; const float* be; unsigned* cnt; int* list;
    __device__ __forceinline__ void operator()(const f32x4 (&acc)[2][2][4][2], const pg::GUnit& u, int wr, int wc, int fr, int fq) const {
        if (wc != 0) return;
        float bev[8];
#pragma unroll
        for (int j = 0; j < 8; ++j) bev[j] = be[fq * 8 + j];
        const float bgv = bg[fq];
#pragma unroll
        for (int ai = 0; ai < 2; ++ai)
#pragma unroll
            for (int m = 0; m < 4; ++m) {
                const int row = u.i0 * 256 + ai * 128 + wr * 64 + m * 16 + fr;
                float el[8];
#pragma unroll
                for (int j = 0; j < 4; ++j) { el[j] = acc[ai][0][m][0][j] + bev[j]; el[4 + j] = acc[ai][0][m][1][j] + bev[4 + j]; }
                const float gl = acc[ai][1][m][0][0] + bgv;
                float gk[4];
#pragma unroll
                for (int k = 0; k < 4; ++k) gk[k] = __shfl(gl, k * 16 + fr);
                int gi = 0; float gm = gk[0];
#pragma unroll
                for (int k = 1; k < 4; ++k) if (gk[k] > gm) { gm = gk[k]; gi = k; }
                float se = 0.f;
#pragma unroll
                for (int k = 0; k < 4; ++k) se += __expf(gk[k] - gm);
                const float pgv = 1.0f / se;
                if (fq == gi) {
                    float v1 = -3.0e38f, v2 = -3.0e38f; int i1 = 0, i2 = 0;
#pragma unroll
                    for (int j = 0; j < 8; ++j) { const float v = el[j]; if (v > v1) { v2 = v1; i2 = i1; v1 = v; i1 = j; } else if (v > v2) { v2 = v; i2 = j; } }
                    const float e2 = __expf(v2 - v1), w1 = pgv / (1.0f + e2), w2 = pgv * e2 / (1.0f + e2);
                    const int ea = gi * 8 + i1, eb = gi * 8 + i2;
                    const unsigned pa = atomicAdd(cnt + ea, 1u), pb = atomicAdd(cnt + eb, 1u);
                    list[ea * LIST_CAP + pa] = (int)((f2bf(w1) << 16) | (unsigned)(row * 2)); list[eb * LIST_CAP + pb] = (int)((f2bf(w2) << 16) | (unsigned)(row * 2 + 1));
                }
            }
    }
};
__device__ __forceinline__ void moe_tile_table(Frame& F, const unsigned* cnt) {
    LAS int* tb = (LAS int*)(F.lds + LDSCTL_OFF); LAS int* cn = tb + 33;
    if (F.tid == 0) { int s = 0; for (int e = 0; e < NE; ++e) { const int c = (int)__hip_atomic_load(cnt + e, __ATOMIC_RELAXED, __HIP_MEMORY_SCOPE_AGENT); tb[e] = s; cn[e] = c; s += (c + 255) >> 8; } tb[NE] = s; }
    __syncthreads();
}
__device__ __forceinline__ bool moe_find(LAS const int* tb, int mt, int& e, int& ti, int& nrows) {
    const int tot = __builtin_amdgcn_readfirstlane(tb[NE]); if (mt >= tot) return false;
    int ee = 0;
#pragma unroll 1
    for (int k = 1; k < NE; ++k) if (tb[k] <= mt) ee = k;
    ee = __builtin_amdgcn_readfirstlane(ee);
    const int t0 = __builtin_amdgcn_readfirstlane(tb[ee]), c = __builtin_amdgcn_readfirstlane(tb[33 + ee]);
    e = ee; ti = mt - t0; const int rem = c - ti * 256; nrows = rem < 256 ? rem : 256; return true;
}
struct SchedMoe1 { int c, Gd; LAS const int* tb; const char* hn; const char* Bt; const int* list;
    __device__ bool next(int i, pg::GUnit& u) const { const int Li = i * Gd + c, mt = Li >> 1, pn = Li & 1; int e, ti, nr; if (!moe_find(tb, mt, e, ti, nr)) return false;
        u.a0 = hn; u.a1 = hn; u.b0 = Bt + ((size_t)e * 512 + pn * 256) * 2048; u.b1 = u.b0 + 128 * 2048; u.nt = 16; u.nt2 = 0;
        u.rows = list + (size_t)e * LIST_CAP + ti * 256; u.nrows = nr; u.i0 = mt; u.i1 = pn; return true; }
};
struct EpiMoe1 { static constexpr bool PERM = true, AFTER_DRAIN = false; bf16_t* hmid;
    __device__ __forceinline__ void operator()(const f32x4 (&acc)[2][2][4][2], const pg::GUnit& u, int wr, int wc, int fr, int fq) const {
        const int row0 = u.i0 * 256 + wr * 64 + fr, col = u.i1 * 128 + wc * 32 + 8 * fq;
#pragma unroll
        for (int ai = 0; ai < 2; ++ai)
#pragma unroll
            for (int m = 0; m < 4; ++m) { const f32x4 a0 = acc[ai][0][m][0], a1 = acc[ai][0][m][1], b0 = acc[ai][1][m][0], b1 = acc[ai][1][m][1]; float y[8];
#pragma unroll
                for (int j = 0; j < 4; ++j) { y[j] = fast_silu(a0[j]) * b0[j]; y[4 + j] = fast_silu(a1[j]) * b1[j]; }
                u32x4 w; w.x = pk2(y[0], y[1]); w.y = pk2(y[2], y[3]); w.z = pk2(y[4], y[5]); w.w = pk2(y[6], y[7]);
                *(u32x4*)(hmid + (size_t)(row0 + ai * 128 + m * 16) * 256 + col) = w; }
    }
};
struct SchedMoe2 { int c, Gd; LAS const int* tb; const char* hmid; const char* Bt; const int* list;
    __device__ bool next(int i, pg::GUnit& u) const { const int Li = i * Gd + c, mt = Li >> 2, pn = Li & 3; int e, ti, nr; if (!moe_find(tb, mt, e, ti, nr)) return false;
        u.a0 = hmid + (size_t)mt * 256 * 512; u.a1 = u.a0 + 128 * 512; u.b0 = Bt + ((size_t)e * 1024 + pn * 256) * 512; u.b1 = u.b0 + 128 * 512; u.nt = 4; u.nt2 = 0;
        u.rows = list + (size_t)e * LIST_CAP + ti * 256; u.nrows = nr; u.i0 = mt; u.i1 = pn; return true; }
};
struct EpiMoe2 { static constexpr bool PERM = true, AFTER_DRAIN = false; bf16_t* y0  ;
    __device__ __forceinline__ void operator()(const f32x4 (&acc)[2][2][4][2], const pg::GUnit& u, int wr, int wc, int fr, int fq) const {
        const int r0 = wr * 64 + fr, col = u.i1 * 256 + wc * 32 + 8 * fq;
        unsigned ent[2][4];
#pragma unroll
        for (int ai = 0; ai < 2; ++ai)
#pragma unroll
            for (int m = 0; m < 4; ++m) { const int r = r0 + ai * 128 + m * 16; ent[ai][m] = (r < u.nrows) ? (unsigned)u.rows[r] : 0xffffffffu; }
#pragma unroll
        for (int ai = 0; ai < 2; ++ai)
#pragma unroll
            for (int m = 0; m < 4; ++m) { const unsigned e = ent[ai][m];
                if (e != 0xffffffffu) { const float w = bfhi(e); const unsigned ts = e & 0xffffu;
                    const unsigned off = ((ts & 1u) * (unsigned)T + (ts >> 1)) * (unsigned)D + (unsigned)col;
#pragma unroll
                    for (int bj = 0; bj < 2; ++bj) { const f32x4 v0 = acc[ai][bj][m][0], v1 = acc[ai][bj][m][1];
                        u32x4 o; o.x = pk2(v0[0] * w, v0[1] * w); o.y = pk2(v0[2] * w, v0[3] * w); o.z = pk2(v1[0] * w, v1[1] * w); o.w = pk2(v1[2] * w, v1[3] * w);
                        *(u32x4*)(y0 + off + bj * 128) = o; } } }
    }
};
template <bool OUT_F32, int NNORM>
__device__ __forceinline__ void rows_combine(Frame& F, const bf16_t* h, const bf16_t* y0, const bf16_t* y1, const float* gmod  , bf16_t* hb, float* hf,
                                              const float* gA, const float* modA, bf16_t* dA, const float* gB, const float* modB, bf16_t* dB) {
    const int rows_per_blk = T / F.G;
    for (int r0 = F.vcu * rows_per_blk; r0 < T; r0 += F.G * rows_per_blk) {
        const int b = r0 / L;
        for (int row = r0 + F.wave; row < r0 + rows_per_blk; row += NWAVES) {
            float v[16];
#pragma unroll
            for (int hlf = 0; hlf < 2; ++hlf) { const size_t off = (size_t)row * D + hlf * 512 + F.lane * 8; const int d0 = hlf * 512 + F.lane * 8;
                const u32x4 xh = *(const u32x4*)(h + off), a = *(const u32x4*)(y0 + off), c = *(const u32x4*)(y1 + off);
                const f32x4 g0 = *(const f32x4*)(gmod + b * 3072 + 2048 + d0), g1 = *(const f32x4*)(gmod + b * 3072 + 2048 + d0 + 4);
                v[hlf * 8 + 0] = bflo(xh.x) + g0.x * (bflo(a.x) + bflo(c.x)); v[hlf * 8 + 1] = bfhi(xh.x) + g0.y * (bfhi(a.x) + bfhi(c.x));
                v[hlf * 8 + 2] = bflo(xh.y) + g0.z * (bflo(a.y) + bflo(c.y)); v[hlf * 8 + 3] = bfhi(xh.y) + g0.w * (bfhi(a.y) + bfhi(c.y));
                v[hlf * 8 + 4] = bflo(xh.z) + g1.x * (bflo(a.z) + bflo(c.z)); v[hlf * 8 + 5] = bfhi(xh.z) + g1.y * (bfhi(a.z) + bfhi(c.z));
                v[hlf * 8 + 6] = bflo(xh.w) + g1.z * (bflo(a.w) + bflo(c.w)); v[hlf * 8 + 7] = bfhi(xh.w) + g1.w * (bfhi(a.w) + bfhi(c.w));
                if constexpr (OUT_F32) { *(f32x4*)(hf + off) = (f32x4){v[hlf * 8 + 0], v[hlf * 8 + 1], v[hlf * 8 + 2], v[hlf * 8 + 3]}; *(f32x4*)(hf + off + 4) = (f32x4){v[hlf * 8 + 4], v[hlf * 8 + 5], v[hlf * 8 + 6], v[hlf * 8 + 7]}; }
                else { u32x4 o; o.x = pk2(v[hlf * 8 + 0], v[hlf * 8 + 1]); o.y = pk2(v[hlf * 8 + 2], v[hlf * 8 + 3]); o.z = pk2(v[hlf * 8 + 4], v[hlf * 8 + 5]); o.w = pk2(v[hlf * 8 + 6], v[hlf * 8 + 7]); *(u32x4*)(hb + off) = o; } }
            if constexpr (NNORM > 0) {
                float ss = 0.f;
#pragma unroll
                for (int j = 0; j < 16; ++j) ss += v[j] * v[j];
                const float rstd = 1.0f / sqrtf(wave_sum(ss) * (1.0f / D) + EPS);
#pragma unroll
                for (int which = 0; which < NNORM; ++which) { const float* g = which ? gB : gA; const float* mod = which ? modB : modA; bf16_t* dst = which ? dB : dA;
#pragma unroll
                    for (int hlf = 0; hlf < 2; ++hlf) { const int d0 = hlf * 512 + F.lane * 8; float y[8];
#pragma unroll
                        for (int j = 0; j < 8; ++j) y[j] = v[hlf * 8 + j] * rstd * g[d0 + j] * (1.0f + mod[b * 3072 + 1024 + d0 + j]) + mod[b * 3072 + d0 + j];
                        u32x4 o; o.x = pk2(y[0], y[1]); o.y = pk2(y[2], y[3]); o.z = pk2(y[4], y[5]); o.w = pk2(y[6], y[7]);
                        *(u32x4*)(dst + (size_t)row * D + d0) = o; } }
            }
        }
    }
}

__device__ __forceinline__ void ph_route(Frame& F, int l, const bf16_t* hn) {
    unsigned char* ws = F.ws; unsigned* ctl = (unsigned*)(ws + WS_CTL);
    SchedDense S; S.o.init(T, 256, F.G, (int)blockIdx.x); S.A = (const char*)hn; S.B = (const char*)(ws + WS_BT_R) + (size_t)l * 256 * 2048; S.apitch = 2048; S.bpitch = 2048; S.nt = 16;
    EpiRoute E{F.in[I_MBG] + l * 4, F.in[I_MBE] + l * 32, ctl + CW_CNT + l * 32, (int*)(ws + WS_LIST)};
    pg::KStep ks{128, 128, 0, 0}; pg::LaneOff lo_{}; pg::lane_off_rowmajor(lo_.a, 2048, false); pg::lane_off_rowmajor(lo_.b, 2048, false);
    pg::gemm_phase<EpiRoute, SchedDense, false, false, false>(F.lds, S, E, ks, lo_, 0);
}
__device__ __forceinline__ void ph_moe_up(Frame& F, int l, const bf16_t* hn, bf16_t* hmid) {
    unsigned char* ws = F.ws; unsigned* ctl = (unsigned*)(ws + WS_CTL);
    moe_tile_table(F, ctl + CW_CNT + l * 32);
    SchedMoe1 S{F.vcu, F.G, (LAS const int*)(F.lds + LDSCTL_OFF), (const char*)hn, (const char*)(ws + WS_BT1) + (size_t)l * 32 * 512 * 2048, (const int*)(ws + WS_LIST)};
    EpiMoe1 E{hmid}; pg::KStep ks{128, 128, 0, 0}; pg::LaneOff lo_{}; pg::lane_off_rowmajor(lo_.a, 0, false); pg::lane_off_rowmajor(lo_.b, 2048, true);
    pg::gemm_phase<EpiMoe1, SchedMoe1, false, true, true>(F.lds, S, E, ks, lo_, 2048);
}
__device__ __forceinline__ void ph_moe_down(Frame& F, int l, const bf16_t* hmid, bf16_t* y0, bf16_t* y1) {
    unsigned char* ws = F.ws; unsigned* ctl = (unsigned*)(ws + WS_CTL);
    moe_tile_table(F, ctl + CW_CNT + l * 32);
    SchedMoe2 S{F.vcu, F.G, (LAS const int*)(F.lds + LDSCTL_OFF), (const char*)hmid, (const char*)(ws + WS_BT2) + (size_t)l * 32 * 1024 * 512, (const int*)(ws + WS_LIST)};
    EpiMoe2 E{y0}; (void)y1; pg::KStep ks{128, 128, 0, 0}; pg::LaneOff lo_{}; pg::lane_off_rowmajor(lo_.a, 512, false); pg::lane_off_rowmajor(lo_.b, 512, true);
    pg::gemm_phase<EpiMoe2, SchedMoe2, false, false, true>(F.lds, S, E, ks, lo_, 0);
}
struct SchedHeads { pg::DenseOrder o; const char* A; const char* B; const char* Bx  ;
    __device__ bool next(int i, pg::GUnit& u) const { int pm, pn; if (!o.next(i, pm, pn)) return false;
        u.a0 = A + (size_t)pm * 256 * 2048; u.a1 = u.a0 + 128 * 2048; u.b0 = (pn < 8) ? B + (size_t)pn * 256 * 2048 : Bx; u.b1 = u.b0 + 128 * 2048; u.nt = 16; u.nt2 = 0; u.i0 = pm; u.i1 = pn; return true; }
};
template <int MODE>
struct EpiHeads { static constexpr bool PERM = false, AFTER_DRAIN = false; bf16_t* d0; bf16_t* d1; const float* ng; const float* fb; float* logf;
    __device__ __forceinline__ void operator()(const f32x4 (&acc)[2][2][4][2], const pg::GUnit& u, int wr, int wc, int fr, int fq) const {
        const int pn = u.i1, row0 = u.i0 * 256 + wr * 64 + fr;
        if (pn < 8) {
            const bool normed = pn < 4; bf16_t* dst = normed ? d0 : d1; const int col = ((pn & 3) * 4 + wc) * 64 + 16 * fq;
            float gv[16];
#pragma unroll
            for (int j = 0; j < 16; ++j) gv[j] = ng[16 * fq + j] * (MODE == 1 ? C2Q : 1.0f);
#pragma unroll
            for (int ai = 0; ai < 2; ++ai)
#pragma unroll
                for (int m = 0; m < 4; ++m) { float v[16];
#pragma unroll
                    for (int bj = 0; bj < 2; ++bj)
#pragma unroll
                        for (int n = 0; n < 2; ++n)
#pragma unroll
                            for (int j = 0; j < 4; ++j) v[8 * bj + 4 * n + j] = acc[ai][bj][m][n][j];
                    if (normed) { float ss = 0.f;
#pragma unroll
                        for (int j = 0; j < 16; ++j) ss += v[j] * v[j];
                        ss += __shfl_xor(ss, 16); ss += __shfl_xor(ss, 32);
                        const float rstd = 1.0f / sqrtf(ss * (1.0f / 64.0f) + EPS);
#pragma unroll
                        for (int j = 0; j < 16; ++j) v[j] = v[j] * rstd * gv[j]; }
                    else if (MODE == 1) {
#pragma unroll
                        for (int j = 0; j < 16; ++j) v[j] = fast_sigmoid(v[j]); }
                    u32x4 o0, o1; o0.x = pk2(v[0], v[1]); o0.y = pk2(v[2], v[3]); o0.z = pk2(v[4], v[5]); o0.w = pk2(v[6], v[7]); o1.x = pk2(v[8], v[9]); o1.y = pk2(v[10], v[11]); o1.z = pk2(v[12], v[13]); o1.w = pk2(v[14], v[15]);
                    bf16_t* p = dst + (size_t)(row0 + ai * 128 + m * 16) * D + col; *(u32x4*)p = o0; *(u32x4*)(p + 8) = o1; }
        } else if (MODE == 0) {
            if (wc != 0) return;
            float fbv[4];
#pragma unroll
            for (int j = 0; j < 4; ++j) fbv[j] = fb[4 * fq + j];
#pragma unroll
            for (int ai = 0; ai < 2; ++ai)
#pragma unroll
                for (int m = 0; m < 4; ++m) { const int row = row0 + ai * 128 + m * 16, b = row / L, t = row % L;
#pragma unroll
                    for (int j = 0; j < 4; ++j) { const float z = acc[ai][0][m][0][j] + fbv[j]; const float ls = fminf(z, 0.f) - log1pf(__expf(-fabsf(z)));
                        logf[((size_t)b * H + 4 * fq + j) * L + t] = ls; } }
        }
    }
};
struct EpiRes { static constexpr bool PERM = true, AFTER_DRAIN = false; const bf16_t* hin; const float* mod; bf16_t* hout;
    __device__ __forceinline__ void operator()(const f32x4 (&acc)[2][2][4][2], const pg::GUnit& u, int wr, int wc, int fr, int fq) const {
        const int row0 = u.i0 * 256 + wr * 64 + fr, col0 = u.i1 * 256 + wc * 32 + 8 * fq, b = (u.i0 * 256) / L;
#pragma unroll
        for (int bj = 0; bj < 2; ++bj) { const int col = col0 + bj * 128; float gt[8];
#pragma unroll
            for (int j = 0; j < 8; ++j) gt[j] = mod[b * 3072 + 2048 + col + j];
#pragma unroll
            for (int ai = 0; ai < 2; ++ai)
#pragma unroll
                for (int m = 0; m < 4; ++m) { const size_t off = (size_t)(row0 + ai * 128 + m * 16) * D + col; const u32x4 hh = *(const u32x4*)(hin + off);
                    const f32x4 a0 = acc[ai][bj][m][0], a1 = acc[ai][bj][m][1];
                    u32x4 w; w.x = pk2(bflo(hh.x) + gt[0] * a0[0], bfhi(hh.x) + gt[1] * a0[1]); w.y = pk2(bflo(hh.y) + gt[2] * a0[2], bfhi(hh.y) + gt[3] * a0[3]);
                    w.z = pk2(bflo(hh.z) + gt[4] * a1[0], bfhi(hh.z) + gt[5] * a1[1]); w.w = pk2(bflo(hh.w) + gt[6] * a1[2], bfhi(hh.w) + gt[7] * a1[3]);
                    *(u32x4*)(hout + off) = w; } }
    }
};
#ifndef REP_MASK
#define REP_MASK 0
#endif
__global__ void __launch_bounds__(NTHR, 2) mk_fwd(Args args) {
    extern __shared__ __attribute__((aligned(16))) unsigned char lds_raw[];
    Frame F;
    F.lds = (LAS unsigned char*)lds_raw; F.ws = args.ws; F.in = args.in; F.out = args.out;
    F.tid = threadIdx.x; F.lane = F.tid & 63; F.wave = __builtin_amdgcn_readfirstlane(F.tid >> 6);
    F.G = gridDim.x; { const int bx = blockIdx.x; F.vcu = (F.G % 8 == 0) ? (bx % 8) * (F.G / 8) + bx / 8 : bx; }
    unsigned char* ws = args.ws;
    unsigned* ctl = (unsigned*)(ws + WS_CTL);
    volatile LAS unsigned* MISC = (volatile LAS unsigned*)(F.lds + MISC_OFF);
    for (int u = F.tid; u < (LDS_BYTES - LDSCTL_OFF) / 4; u += NTHR) ((LAS unsigned*)(F.lds + LDSCTL_OFF))[u] = 0u;
    __syncthreads();
    const int lo = args.ph_lo, hi = args.ph_hi;
    const bool multi = (hi - lo) > 1;
    XcdBarrier bar; bar.bar = ctl + CW_BAR; bar.x = 0; bar.st = nullptr;
    if (multi) bar = xcd_barrier_post(ctl + CW_BAR, MISC + 8);
#define IN(k) (lo <= (k) && (k) < hi)
#define SEAM(k) do { if (IN(k) && IN((k) + 1)) xcd_barrier(bar); } while (0)
    float* mods = (float*)(ws + WS_MODS);
    bf16_t* S0 = (bf16_t*)(ws + SLOTP(0)); bf16_t* S1 = (bf16_t*)(ws + SLOTP(1)); bf16_t* S2 = (bf16_t*)(ws + SLOTP(2)); bf16_t* S3 = (bf16_t*)(ws + SLOTP(3)); bf16_t* S4 = (bf16_t*)(ws + SLOTP(4)); bf16_t* S5 = (bf16_t*)(ws + SLOTP(5));
    (void)S5;
    if (IN(0)) for (int rep_ = 0; rep_ < 1 + ((REP_MASK >> 0) & 1); ++rep_) { if (rep_) xcd_barrier(bar); for (int q_ = 0; q_ < 1 + ((REP_MASK >> 20) & 1); ++q_) { p0_mods(F); __syncthreads(); } for (int q_ = 0; q_ < 1 + ((REP_MASK >> 21) & 1); ++q_) { p0_convert(F); __syncthreads(); } for (int q_ = 0; q_ < 1 + ((REP_MASK >> 22) & 1); ++q_) p0_s5_tables(F); }
    SEAM(0);
    if (IN(1)) for (int rep_ = 0; rep_ < 1 + ((REP_MASK >> 1) & 1); ++rep_) { if (rep_) xcd_barrier(bar); rows_norm_mod<true>(F, F.in[I_X], F.in[I_LNG], mods, S0); }
    SEAM(1);
    if (IN(2)) for (int rep_ = 0; rep_ < 1 + ((REP_MASK >> 2) & 1); ++rep_) { if (rep_) xcd_barrier(bar); SchedDense S; S.o.init(T, D, F.G, (int)blockIdx.x); S.A = (const char*)S0; S.B = (const char*)(ws + WS_BT_IN); S.apitch = 2048; S.bpitch = 2048; S.nt = 16;
        EpiToGM E{S1}; pg::KStep ks{128, 128, 0, 0}; pg::LaneOff lo_{}; pg::lane_off_rowmajor(lo_.a, 2048, false); pg::lane_off_rowmajor(lo_.b, 2048, true);
        pg::gemm_phase<EpiToGM, SchedDense, false, false, true>(F.lds, S, E, ks, lo_, 0); }
    SEAM(2);
    if (IN(3)) for (int rep_ = 0; rep_ < 1 + ((REP_MASK >> 3) & 1); ++rep_) { if (rep_) xcd_barrier(bar); SchedE S{F.vcu, F.G, (const char*)S1, (const char*)(ws + WS_WB)};
        EpiScan E{S3, (const f32x2*)(ws + WS_A64)}; pg::KStep ks{128, 128, 0, 0}; pg::LaneOff lo_{}; pg::lane_off_rowmajor(lo_.a, 2048, false); pg::lane_off_rowmajor(lo_.b, 2048, false);
        pg::gemm_phase<EpiScan, SchedE, false, false, false>(F.lds, S, E, ks, lo_, 0); }
    SEAM(3);
    if (IN(4)) for (int rep_ = 0; rep_ < 1 + ((REP_MASK >> 4) & 1); ++rep_) { if (rep_) xcd_barrier(bar); SchedY S{F.vcu, F.G, (const char*)S1, (const char*)S3, (const char*)(ws + WS_KTAB), (const char*)(ws + WS_VT)};
        EpiY E{S1, S2, F.in[I_DSK]}; pg::KStep ks{128, -2048, 128, 128}; pg::LaneOff lo_{};
        pg::lane_off_rowmajor(lo_.a, 2048, false); pg::lane_off_rowmajor(lo_.a2, 256, false); pg::lane_off_rowmajor(lo_.b2, 256, true);
#pragma unroll
        for (int i = 0; i < 2; ++i) { int R, C; int tq = threadIdx.x; asm volatile("" : "+v"(tq)); pg::stage_rc(tq * 16 + i * 8192, R, C); const int Rb = (R & ~31) + pg::perm32(R & 31); lo_.b[i] = (((Rb >> 4) - (C >> 4)) * 256 + (Rb & 15) * 16 + (C & 15)) * 2; }
        pg::gemm_phase<EpiY, SchedY, true, false, true>(F.lds, S, E, ks, lo_, 0); }
    SEAM(4);
    if (IN(5)) for (int rep_ = 0; rep_ < 1 + ((REP_MASK >> 5) & 1); ++rep_) { if (rep_) xcd_barrier(bar); SchedOut S; S.o.init(T, 2048, F.G, (int)blockIdx.x); S.Y = (const char*)S2; S.B = (const char*)(ws + WS_BT_OUT);
        EpiGluRes E{F.in[I_X], mods, S4}; pg::KStep ks{(long)4 * T * 32, 128, 0, 0}; pg::LaneOff lo_{}; pg::lane_off_rowmajor(lo_.b, 2048, true);
#pragma unroll
        for (int i = 0; i < 2; ++i) { int R, C; int tq = threadIdx.x; asm volatile("" : "+v"(tq)); pg::stage_rc(tq * 16 + i * 8192, R, C); lo_.a[i] = R * 32 + (C >> 4) * (T * 32) + (C & 15) * 2; }
        pg::gemm_phase<EpiGluRes, SchedOut, false, false, true>(F.lds, S, E, ks, lo_, 0); }
    SEAM(5);
    if (IN(6)) for (int rep_ = 0; rep_ < 1 + ((REP_MASK >> 6) & 1); ++rep_) { if (rep_) xcd_barrier(bar); rows_norm_mod<false>(F, S4, F.in[I_LNG] + D, mods + 1 * NB * 3072, S0); }
    SEAM(6);
    if (IN(7)) for (int rep_ = 0; rep_ < 1 + ((REP_MASK >> 7) & 1); ++rep_) { if (rep_) xcd_barrier(bar); ph_route(F, 0, S0); }
    SEAM(7);
    if (IN(8)) for (int rep_ = 0; rep_ < 1 + ((REP_MASK >> 8) & 1); ++rep_) { if (rep_) xcd_barrier(bar); ph_moe_up(F, 0, S0, S1); }
    SEAM(8);
    if (IN(9)) for (int rep_ = 0; rep_ < 1 + ((REP_MASK >> 9) & 1); ++rep_) { if (rep_) xcd_barrier(bar); ph_moe_down(F, 0, S1, S2, S3); }
    SEAM(9);
    if (IN(10)) for (int rep_ = 0; rep_ < 1 + ((REP_MASK >> 10) & 1); ++rep_) { if (rep_) xcd_barrier(bar); rows_combine<false, 2>(F, S4, S2, S3, mods + 1 * NB * 3072, S5, nullptr, F.in[I_KVG], mods + 4 * NB * 3072, S1, F.in[I_LNG] + 2 * D, mods + 2 * NB * 3072, S0); }
    SEAM(10);
    if (IN(11)) for (int rep_ = 0; rep_ < 1 + ((REP_MASK >> 11) & 1); ++rep_) { if (rep_) xcd_barrier(bar); SchedHeads S; S.o.init(T, 9 * 256, F.G, (int)blockIdx.x); S.A = (const char*)S1; S.B = (const char*)(ws + WS_BT_KV); S.Bx = (const char*)(ws + WS_BT_FZ);
        EpiHeads<0> E{S2, S3, F.in[I_KNG], F.in[I_KVFB], (float*)(ws + WS_LOGF)}; pg::KStep ks{128, 128, 0, 0}; pg::LaneOff lo_{}; pg::lane_off_rowmajor(lo_.a, 2048, false); pg::lane_off_rowmajor(lo_.b, 2048, false);
        pg::gemm_phase<EpiHeads<0>, SchedHeads, false, false, true>(F.lds, S, E, ks, lo_, 0); }
    SEAM(11);
    if (IN(12)) for (int rep_ = 0; rep_ < 1 + ((REP_MASK >> 12) & 1); ++rep_) { if (rep_) xcd_barrier(bar); SchedHeads S; S.o.init(T, 8 * 256, F.G, (int)blockIdx.x); S.A = (const char*)S0; S.B = (const char*)(ws + WS_BT_QG); S.Bx = S.B;
        EpiHeads<1> E{S1, S4, F.in[I_QNG], nullptr, nullptr}; pg::KStep ks{128, 128, 0, 0}; pg::LaneOff lo_{}; pg::lane_off_rowmajor(lo_.a, 2048, false); pg::lane_off_rowmajor(lo_.b, 2048, false);
        pg::gemm_phase<EpiHeads<1>, SchedHeads, false, false, true>(F.lds, S, E, ks, lo_, 0); }
    SEAM(12);
    if (IN(13)) for (int rep_ = 0; rep_ < 1 + ((REP_MASK >> 13) & 1); ++rep_) { if (rep_) xcd_barrier(bar); const attn_body::AttnTensors AT{(const attn_body::bf16*)S1, (const attn_body::bf16*)S2, (const attn_body::bf16*)S3, (attn_body::bf16*)S0, (const attn_body::bf16*)S4, (const float*)(ws + WS_LOGF)};
        const attn_body::StaticOrder S((int)F.G, F.vcu);
        attn_body::attn_phase<attn_body::StaticOrder>((char*)lds_raw, AT, S, F.in[I_QNG], F.in[I_KNG]); }
    SEAM(13);
    if (IN(14)) for (int rep_ = 0; rep_ < 1 + ((REP_MASK >> 14) & 1); ++rep_) { if (rep_) xcd_barrier(bar); SchedDense S; S.o.init(T, D, F.G, (int)blockIdx.x); S.A = (const char*)S0; S.B = (const char*)(ws + WS_BT_O); S.apitch = 2048; S.bpitch = 2048; S.nt = 16;
        EpiRes E{S5, mods + 2 * NB * 3072, S4}; pg::KStep ks{128, 128, 0, 0}; pg::LaneOff lo_{}; pg::lane_off_rowmajor(lo_.a, 2048, false); pg::lane_off_rowmajor(lo_.b, 2048, true);
        pg::gemm_phase<EpiRes, SchedDense, false, false, true>(F.lds, S, E, ks, lo_, 0); }
    SEAM(14);
    if (IN(15)) for (int rep_ = 0; rep_ < 1 + ((REP_MASK >> 15) & 1); ++rep_) { if (rep_) xcd_barrier(bar); rows_norm_mod<false>(F, S4, F.in[I_LNG] + 3 * D, mods + 3 * NB * 3072, S0); }
    SEAM(15);
    if (IN(16)) for (int rep_ = 0; rep_ < 1 + ((REP_MASK >> 16) & 1); ++rep_) { if (rep_) xcd_barrier(bar); ph_route(F, 1, S0); }
    SEAM(16);
    if (IN(17)) for (int rep_ = 0; rep_ < 1 + ((REP_MASK >> 17) & 1); ++rep_) { if (rep_) xcd_barrier(bar); ph_moe_up(F, 1, S0, S1); }
    SEAM(17);
    if (IN(18)) for (int rep_ = 0; rep_ < 1 + ((REP_MASK >> 18) & 1); ++rep_) { if (rep_) xcd_barrier(bar); ph_moe_down(F, 1, S1, S2, S3); }
    SEAM(18);
    if (IN(19)) for (int rep_ = 0; rep_ < 1 + ((REP_MASK >> 19) & 1); ++rep_) { if (rep_) xcd_barrier(bar); rows_combine<true, 0>(F, S4, S2, S3, mods + 3 * NB * 3072, nullptr, F.out, nullptr, nullptr, nullptr, nullptr, nullptr, nullptr); }
#undef IN
#undef SEAM
}
}
#ifndef ONE_LAUNCH
#define ONE_LAUNCH 1
#endif
extern "C" void kernel_launch(void* const* d_in, const int* in_sizes, int n_in, void* d_out, int out_size, void* d_ws, size_t ws_size, hipStream_t stream) {
    static int grid = 0;
    if (grid == 0) {
        if (n_in != 31 || out_size != mk::T * mk::D || ws_size < mk::WS_END) { fprintf(stderr, "kernel_launch: unexpected shapes / workspace (n_in %d, out %d, ws %zu < %zu)\n", n_in, out_size, ws_size, (size_t)mk::WS_END); grid = -1; return; }
        int dev = 0, cus = 0, per_cu = 0;
        if (hipGetDevice(&dev) != hipSuccess || hipDeviceGetAttribute(&cus, hipDeviceAttributeMultiprocessorCount, dev) != hipSuccess) { grid = -1; return; }
        if (hipFuncSetAttribute((const void*)mk::mk_fwd, hipFuncAttributeMaxDynamicSharedMemorySize, mk::LDS_BYTES) != hipSuccess) { fprintf(stderr, "kernel_launch: hipFuncSetAttribute failed\n"); grid = -1; return; }
        if (hipOccupancyMaxActiveBlocksPerMultiprocessor(&per_cu, (const void*)mk::mk_fwd, mk::NTHR, mk::LDS_BYTES) != hipSuccess || per_cu < 1) { fprintf(stderr, "kernel_launch: occupancy query says %d workgroups per CU\n", per_cu); grid = -1; (void)hipGetLastError(); return; }
        grid = cus;
    }
    if (grid < 0) return;
    (void)hipMemsetAsync((char*)d_ws + mk::WS_CTL, 0, mk::CTL_ZERO_BYTES, stream);
    mk::Args a{};
    for (int i = 0; i < 31; ++i) a.in[i] = (const float*)d_in[i];
    a.out = (float*)d_out; a.ws = (unsigned char*)d_ws;
    constexpr int NPH = 20;
#if ONE_LAUNCH
    a.ph_lo = 0; a.ph_hi = NPH; hipLaunchKernelGGL(mk::mk_fwd, dim3(grid), dim3(mk::NTHR), mk::LDS_BYTES, stream, a);
#else
    for (int p = 0; p < NPH; ++p) { a.ph_lo = p; a.ph_hi = p + 1; hipLaunchKernelGGL(mk::mk_fwd, dim3(grid), dim3(mk::NTHR), mk::LDS_BYTES, stream, a); }
#endif
}
```
